# Optimizing an MI355X kernel written in HIP

```python
import jax, jax.numpy as jnp
from jax import lax
import numpy as np

D_MODEL = 1024
BATCH = 4
SEQ = 4096
DEPTH = 2

N_A = DEPTH // 2
N_B = DEPTH - N_A

LRU_WIDTH = D_MODEL
LRU_HEADS = 8
LRU_BLOCK = LRU_WIDTH // LRU_HEADS
LRU_CONV = 4
LRU_C = 8.0

N_HEADS = 8
HEAD_DIM = D_MODEL // N_HEADS
Q_BLOCK = 128

D_FF = 3 * D_MODEL
FFN_CONV = 3

DN_ALPHA = (2 * DEPTH) ** 0.25
DN_BETA = (8 * DEPTH) ** -0.25
LN_EPS = 1e-5

kernel_name = "yoco_rglru_stickbreak_convffn_deepnorm"


def layer_norm(x, g, b):
    xf = x.astype(jnp.float32)
    mu = jnp.mean(xf, axis=-1, keepdims=True)
    xc = xf - mu
    var = jnp.mean(xc * xc, axis=-1, keepdims=True)
    y = xc * lax.rsqrt(var + LN_EPS) * g.astype(jnp.float32) + b.astype(jnp.float32)
    return y.astype(x.dtype)


def causal_depthwise_conv(x, w, b):
    K = w.shape[0]
    S = x.shape[1]
    xp = jnp.pad(x, ((0, 0), (K - 1, 0), (0, 0)))
    y = b + xp[:, 0:S] * w[0]
    for k in range(1, K):
        y = y + xp[:, k:k + S] * w[k]
    return y


def _lin_combine(left, right):
    a1, b1 = left
    a2, b2 = right
    return a1 * a2, a2 * b1 + b2


def rg_lru_block(x, w_in, b_in, conv_w, conv_b, w_gates, b_gates, a_param, w_out, b_out):
    B, S, _ = x.shape
    proj = x @ w_in + b_in
    y_br = jax.nn.gelu(proj[..., :LRU_WIDTH])
    x_br = causal_depthwise_conv(proj[..., LRU_WIDTH:], conv_w, conv_b)
    xb = x_br.reshape(B, S, LRU_HEADS, LRU_BLOCK)
    gates = jnp.einsum('bsnc,ncg->bsng', xb, w_gates) + b_gates
    gates = jax.nn.sigmoid(gates.astype(jnp.float32))
    gate_i = gates[..., :LRU_BLOCK].reshape(B, S, LRU_WIDTH)
    gate_r = gates[..., LRU_BLOCK:].reshape(B, S, LRU_WIDTH)
    log_a = -LRU_C * gate_r * jax.nn.softplus(-a_param.astype(jnp.float32))
    a = jnp.exp(log_a)
    mult = jnp.sqrt(jnp.maximum(1.0 - jnp.exp(2.0 * log_a), 0.0))
    is_start = (jnp.arange(S) == 0)[None, :, None]
    mult = jnp.where(is_start, 1.0, mult)
    u = mult * gate_i * x_br.astype(jnp.float32)
    _, h = lax.associative_scan(_lin_combine, (a, u), axis=1)
    return (h.astype(x.dtype) * y_br) @ w_out + b_out


def stick_breaking_attention(q, k, v):
    B, S, H, Dh = q.shape
    scale = Dh ** -0.5
    outs = []
    for i in range(S // Q_BLOCK):
        q0 = i * Q_BLOCK
        kv_len = q0 + Q_BLOCK
        q_blk = q[:, q0:kv_len]
        k_p = k[:, :kv_len]
        v_p = v[:, :kv_len]
        z = jnp.einsum('bqhd,bkhd->bhqk', q_blk, k_p).astype(jnp.float32) * scale
        q_pos = q0 + jnp.arange(Q_BLOCK)
        k_pos = jnp.arange(kv_len)
        mask = k_pos[None, :] < q_pos[:, None]
        log_beta = jax.nn.log_sigmoid(z)
        log_1m = jnp.where(mask, jax.nn.log_sigmoid(-z), 0.0)
        suffix = lax.cumsum(log_1m, axis=3, reverse=True) - log_1m
        w = jnp.where(mask, jnp.exp(log_beta + suffix), 0.0)
        o = jnp.einsum('bhqk,bkhd->bqhd', w, v_p.astype(jnp.float32))
        outs.append(o.astype(q.dtype))
    return jnp.concatenate(outs, axis=1)


def conv_ffn(x, w_up, conv_w, conv_b, w_down):
    h = causal_depthwise_conv(x @ w_up, conv_w, conv_b)
    return (jax.nn.gelu(h[..., :D_FF]) * h[..., D_FF:]) @ w_down


def setup_inputs(seed: int = 0) -> dict:
    key = jax.random.key(seed)
    ks = jax.random.split(key, 24)
    f32 = jnp.float32

    def nrm(k, shape, fan_in, gain=1.0):
        return jax.random.normal(k, shape, f32) * (gain * fan_in ** -0.5)

    def small(k, shape):
        return 0.01 * jax.random.normal(k, shape, f32)

    W, HD = LRU_WIDTH, N_HEADS * HEAD_DIM
    u = jax.random.uniform(ks[8], (N_A, W), f32, minval=0.9, maxval=0.999)
    s = u ** (1.0 / LRU_C)
    lru_a_param = jnp.log(s) - jnp.log1p(-s)
    kv_w = jnp.concatenate([nrm(ks[11], (D_MODEL, HD), D_MODEL),
                            nrm(ks[12], (D_MODEL, HD), D_MODEL, DN_BETA)], axis=1)
    return {
        "x": jax.random.normal(ks[0], (BATCH, SEQ, D_MODEL), f32),
        "lru_w_in": nrm(ks[1], (N_A, D_MODEL, 2 * W), D_MODEL),
        "lru_b_in": small(ks[2], (N_A, 2 * W)),
        "lru_conv_w": nrm(ks[3], (N_A, LRU_CONV, W), LRU_CONV),
        "lru_conv_b": small(ks[4], (N_A, W)),
        "lru_w_gates": nrm(ks[5], (N_A, LRU_HEADS, LRU_BLOCK, 2 * LRU_BLOCK), LRU_BLOCK),
        "lru_b_gates": small(ks[6], (N_A, LRU_HEADS, 2 * LRU_BLOCK)),
        "lru_a_param": lru_a_param,
        "lru_w_out": nrm(ks[9], (N_A, W, D_MODEL), W, DN_BETA),
        "lru_b_out": small(ks[10], (N_A, D_MODEL)),
        "kv_w": kv_w,
        "attn_w_q": nrm(ks[13], (N_B, D_MODEL, HD), D_MODEL),
        "attn_w_out": nrm(ks[14], (N_B, HD, D_MODEL), HD, DN_BETA),
        "ffn_w_up": nrm(ks[15], (DEPTH, D_MODEL, 2 * D_FF), D_MODEL),
        "ffn_conv_w": nrm(ks[16], (DEPTH, FFN_CONV, 2 * D_FF), FFN_CONV),
        "ffn_conv_b": small(ks[17], (DEPTH, 2 * D_FF)),
        "ffn_w_down": nrm(ks[18], (DEPTH, D_FF, D_MODEL), D_FF, DN_BETA),
        "ln_g": 1.0 + small(ks[19], (DEPTH, 2, D_MODEL)),
        "ln_b": small(ks[20], (DEPTH, 2, D_MODEL)),
    }


def reference(x, lru_w_in, lru_b_in, lru_conv_w, lru_conv_b, lru_w_gates, lru_b_gates,
              lru_a_param, lru_w_out, lru_b_out, kv_w, attn_w_q, attn_w_out,
              ffn_w_up, ffn_conv_w, ffn_conv_b, ffn_w_down, ln_g, ln_b):
    B, S, _ = x.shape
    HD = N_HEADS * HEAD_DIM
    k_sh = None
    v_sh = None
    for layer in range(DEPTH):
        if layer < N_A:
            mix = rg_lru_block(x, lru_w_in[layer], lru_b_in[layer], lru_conv_w[layer],
                               lru_conv_b[layer], lru_w_gates[layer], lru_b_gates[layer],
                               lru_a_param[layer], lru_w_out[layer], lru_b_out[layer])
        else:
            if layer == N_A:
                kv = x @ kv_w
                k_sh = kv[..., :HD].reshape(B, S, N_HEADS, HEAD_DIM)
                v_sh = kv[..., HD:].reshape(B, S, N_HEADS, HEAD_DIM)
            j = layer - N_A
            q = (x @ attn_w_q[j]).reshape(B, S, N_HEADS, HEAD_DIM)
            o = stick_breaking_attention(q, k_sh, v_sh).reshape(B, S, HD)
            mix = o @ attn_w_out[j]
        x = layer_norm(DN_ALPHA * x + mix, ln_g[layer, 0], ln_b[layer, 0])
        f = conv_ffn(x, ffn_w_up[layer], ffn_conv_w[layer], ffn_conv_b[layer], ffn_w_down[layer])
        x = layer_norm(DN_ALPHA * x + f, ln_g[layer, 1], ln_b[layer, 1])
    return x
```

```cpp
#include <hip/hip_runtime.h>
#include <hip/hip_bf16.h>
#include <cstdio>
#include <cstdint>
namespace pg8 {
#define PG8_LAS __attribute__((address_space(3)))
typedef unsigned short bf16_t;
typedef short bf16x8 __attribute__((ext_vector_type(8)));
typedef float f32x4 __attribute__((ext_vector_type(4)));
typedef unsigned u32x4 __attribute__((ext_vector_type(4)));
constexpr int BM = 256, BK = 64, HALF = 128, HTB = HALF * BK * 2  , STAGE_BYTES = 8 * HTB, NXCD = 8, WGM = 8;

__host__ __device__ __forceinline__ int lds_byte(int r, int c) { const int st = (r >> 4) * 2 + (c >> 5), rr = r & 15, cc = c & 31, ob = rr * 64 + cc * 2; return st * 1024 + (ob ^ (((ob >> 9) & 1) << 5)); }
__host__ __device__ __forceinline__ void stage_rc(int b, int& R, int& C) { const int st = b / 1024, sb = b % 1024, swz = sb ^ (((sb >> 9) & 1) << 5); R = (st >> 1) * 16 + swz / 64; C = (st & 1) * 32 + (swz % 64) / 2; }
__host__ __device__ __forceinline__ int perm32(int rho) { const int n = rho >> 4, i = rho & 15; return 8 * (i >> 2) + 4 * n + (i & 3); }

struct Unit { int pm, pn; };
struct Gemm { const bf16_t* A; const bf16_t* Bt; int M, N, K; };

struct StaticOrder {
    int nM, nN, nwg, G, c;
    __host__ __device__ void init(int M, int N, int G_, int c_) { nM = M / BM; nN = N / BM; nwg = nM * nN; G = G_; c = c_; }
    __host__ __device__ bool next(int i, Unit& u) const {
        const long L = (long)i * G + c; if (L >= nwg) return false;
        int wgid = (int)L; { const int q = nwg / NXCD, r = nwg % NXCD, xcd = wgid % NXCD, off = wgid / NXCD; wgid = (xcd < r ? xcd * (q + 1) : r * (q + 1) + (xcd - r) * q) + off; }
        const int nig = WGM * nN, gid = wgid / nig, fm = gid * WGM, gsz = (nM - fm) < WGM ? (nM - fm) : WGM;
        u.pm = fm + ((wgid % nig) % gsz); u.pn = (wgid % nig) / gsz; return true;
    }
    __device__ __forceinline__ void a_ready(const Unit&) const {}
    __device__ __forceinline__ void done(const Unit&) const {}
};

__device__ __forceinline__ unsigned cvt_pk_bf16(float lo, float hi) { unsigned r; asm volatile("v_cvt_pk_bf16_f32 %0, %1, %2" : "=v"(r) : "v"(lo), "v"(hi)); return r; }
typedef float f32x2 __attribute__((ext_vector_type(2)));

__device__ __forceinline__ float gelu_tanh(float v) {
    const float k2 = -2.0f * 0.7978845608028654f * 1.4426950408889634f;
    const float uu = v * (1.0f + 0.044715f * v * v);
    const float e = __builtin_amdgcn_exp2f(k2 * uu);
    return v * __builtin_amdgcn_rcpf(1.0f + e);
}
struct EpiBf16S {
    static constexpr bool PERM = true, AFTER_DRAIN = false;
    bf16_t* O; int ldc; int split_cols; size_t split_stride; float scale0;
    __device__ __forceinline__ void operator()(const f32x4 (&acc)[2][2][4][2], const Unit& u, int wr, int wc, int fr, int fq) const {
        const int row0 = u.pm * BM + wr * 64 + fr; int colt = u.pn * BM; bf16_t* base = O;
        float sc = 1.f; { const int t = colt / split_cols; base += (size_t)t * split_stride; colt -= t * split_cols; if (t == 0) sc = scale0; }
        const int col0 = colt + wc * 32 + 8 * fq;
#pragma unroll
        for (int ai = 0; ai < 2; ++ai)
#pragma unroll
            for (int m = 0; m < 4; ++m) { bf16_t* rowp = base + (size_t)(row0 + ai * HALF + m * 16) * ldc + col0;
#pragma unroll
                for (int bj = 0; bj < 2; ++bj) { f32x4 v0 = acc[ai][bj][m][0] * sc, v1 = acc[ai][bj][m][1] * sc;
                    u32x4 w; w.x = cvt_pk_bf16(v0[0], v0[1]); w.y = cvt_pk_bf16(v0[2], v0[3]); w.z = cvt_pk_bf16(v1[0], v1[1]); w.w = cvt_pk_bf16(v1[2], v1[3]);
                    *(u32x4*)(rowp + bj * HALF) = w; } }
    }
};
struct EpiG1 {
    static constexpr bool PERM = true, AFTER_DRAIN = false;
    bf16_t* Y; bf16_t* XR; const float* bias;
    __device__ __forceinline__ void operator()(const f32x4 (&acc)[2][2][4][2], const Unit& u, int wr, int wc, int fr, int fq) const {
        const int row0 = u.pm * BM + wr * 64 + fr; const int colt = u.pn * BM; const bool isY = colt < 1024;
        bf16_t* base = isY ? Y : XR; const int col0 = (isY ? colt : colt - 1024) + wc * 32 + 8 * fq, bcol0 = colt + wc * 32 + 8 * fq;
        f32x4 bv[2][2];
#pragma unroll
        for (int bj = 0; bj < 2; ++bj)
#pragma unroll
            for (int n = 0; n < 2; ++n) bv[bj][n] = *(const f32x4*)(bias + bcol0 + bj * HALF + 4 * n);
#pragma unroll
        for (int ai = 0; ai < 2; ++ai)
#pragma unroll
            for (int m = 0; m < 4; ++m) { bf16_t* rowp = base + (size_t)(row0 + ai * HALF + m * 16) * 1024 + col0;
#pragma unroll
                for (int bj = 0; bj < 2; ++bj) { f32x4 v0 = acc[ai][bj][m][0] + bv[bj][0], v1 = acc[ai][bj][m][1] + bv[bj][1];
                    if (isY) {
#pragma unroll
                        for (int e = 0; e < 4; ++e) { v0[e] = gelu_tanh(v0[e]); v1[e] = gelu_tanh(v1[e]); } }
                    u32x4 w; w.x = cvt_pk_bf16(v0[0], v0[1]); w.y = cvt_pk_bf16(v0[2], v0[3]); w.z = cvt_pk_bf16(v1[0], v1[1]); w.w = cvt_pk_bf16(v1[2], v1[3]);
                    *(u32x4*)(rowp + bj * HALF) = w; } }
    }
};
struct EpiSum {
    static constexpr bool PERM = false, AFTER_DRAIN = false;
    const float* res; float* out; const float* bias; float alpha;
    __device__ __forceinline__ void operator()(const f32x4 (&acc)[2][2][4][2], const Unit& u, int wr, int wc, int fr, int fq) const {
        const int col0 = u.pn * BM + wc * 32 + 4 * fq;
        f32x4 bv[2][2];
#pragma unroll
        for (int bj = 0; bj < 2; ++bj)
#pragma unroll
            for (int n = 0; n < 2; ++n) bv[bj][n] = bias ? *(const f32x4*)(bias + col0 + bj * HALF + n * 16) : (f32x4){0.f, 0.f, 0.f, 0.f};
#pragma unroll
        for (int ai = 0; ai < 2; ++ai)
#pragma unroll
            for (int m = 0; m < 4; ++m) { const size_t off = (size_t)(u.pm * BM + ai * HALF + wr * 64 + m * 16 + fr) * 1024 + col0;
#pragma unroll
                for (int bj = 0; bj < 2; ++bj)
#pragma unroll
                    for (int n = 0; n < 2; ++n) { const f32x4 r = *(const f32x4*)(res + off + bj * HALF + n * 16);
                        *(f32x4*)(out + off + bj * HALF + n * 16) = r * alpha + acc[ai][bj][m][n] + bv[bj][n]; } }
    }
};
__device__ __forceinline__ float dpp_shr1(float old, float src) { return __builtin_bit_cast(float, __builtin_amdgcn_update_dpp(__builtin_bit_cast(int, old), __builtin_bit_cast(int, src), 0x111, 0xf, 0xf, false)); }
__device__ __forceinline__ float dpp_shr2(float old, float src) { return __builtin_bit_cast(float, __builtin_amdgcn_update_dpp(__builtin_bit_cast(int, old), __builtin_bit_cast(int, src), 0x112, 0xf, 0xf, false)); }
__device__ __forceinline__ float dpp_ror1(float src) { return __builtin_bit_cast(float, __builtin_amdgcn_update_dpp(0, __builtin_bit_cast(int, src), 0x121, 0xf, 0xf, false)); }
__device__ __forceinline__ float dpp_ror2(float src) { return __builtin_bit_cast(float, __builtin_amdgcn_update_dpp(0, __builtin_bit_cast(int, src), 0x122, 0xf, 0xf, false)); }
struct EpiFfnUp {
    static constexpr bool PERM = true, AFTER_DRAIN = false;
    bf16_t* G; const float* cw; const float* cb; float* halo_prev; float* halo_cur; PG8_LAS float* scr;
    __device__ __forceinline__ void operator()(f32x4 (&acc)[2][2][4][2], const Unit& u, int wr, int wc, int fr_, int fq) const {
        int lc0 = wc * 32 + 8 * fq, fr = fr_;
        asm volatile("" : "+v"(lc0), "+v"(fr));
        if (fr >= 14) {
#pragma unroll
            for (int ai = 0; ai < 2; ++ai)
#pragma unroll
                for (int bj = 0; bj < 2; ++bj)
#pragma unroll
                    for (int n = 0; n < 2; ++n) {
                        *(PG8_LAS f32x4*)(scr + (((ai * 2 + wr) * 2 + (fr - 14)) * 256 + bj * 128 + lc0 + 4 * n)) = acc[ai][bj][3][n];
                        if (ai == 1 && wr == 1) *(f32x4*)(halo_prev + ((size_t)(u.pm * 2 + (fr - 14)) * 6144 + u.pn * 256 + bj * 128 + lc0 + 4 * n)) = acc[1][bj][3][n];
                    }
        }
        if (fr < 2 && wr == 0) {
#pragma unroll
            for (int bj = 0; bj < 2; ++bj)
#pragma unroll
                for (int n = 0; n < 2; ++n) *(f32x4*)(halo_cur + ((size_t)(u.pm * 2 + fr) * 6144 + u.pn * 256 + bj * 128 + lc0 + 4 * n)) = acc[0][bj][0][n];
        }
        asm volatile("s_waitcnt lgkmcnt(0)" ::: "memory"); __builtin_amdgcn_s_barrier(); asm volatile("" ::: "memory");
#pragma unroll
        for (int bj = 0; bj < 2; ++bj)
#pragma unroll
            for (int n = 0; n < 2; ++n) {
                const int gc = bj * 3072 + u.pn * 128 + lc0 + 4 * n;
                const f32x4 w0 = *(const f32x4*)(cw + gc), w1 = *(const f32x4*)(cw + 6144 + gc), w2 = *(const f32x4*)(cw + 2 * 6144 + gc), bb = *(const f32x4*)(cb + gc);
#pragma unroll
                for (int ai = 1; ai >= 0; --ai) {
                    f32x4 p62, p63;
                    const int grp = ai * 2 + wr;
                    { const int gp = grp > 0 ? grp - 1 : 0; const bool keep = grp > 0; const f32x4 zz = {0.f, 0.f, 0.f, 0.f};
                      p62 = *(const PG8_LAS f32x4*)(scr + ((gp * 2 + 0) * 256 + bj * 128 + lc0 + 4 * n)); p63 = *(const PG8_LAS f32x4*)(scr + ((gp * 2 + 1) * 256 + bj * 128 + lc0 + 4 * n)); p62 = keep ? p62 : zz; p63 = keep ? p63 : zz; }
#pragma unroll
                    for (int m = 3; m >= 0; --m) {
                        const f32x4 cur = acc[ai][bj][m][n]; f32x4 y;
#pragma unroll
                        for (int e = 0; e < 4; ++e) {
                            float t1, t2;
                            if (m > 0) { t1 = dpp_ror1(acc[ai][bj][m - 1][n][e]); t2 = dpp_ror2(acc[ai][bj][m - 1][n][e]); }
                            else { t1 = p63[e]; t2 = (fr == 0) ? p62[e] : p63[e]; }
                            const float q1 = dpp_shr1(t1, cur[e]), q2 = dpp_shr2(t2, cur[e]);
                            y[e] = bb[e] + w2[e] * cur[e] + w1[e] * q1 + w0[e] * q2;
                        }
                        asm volatile("" : "+v"(y));
                        acc[ai][bj][m][n] = y;
                    }
                    asm volatile("" ::: "memory"); __builtin_amdgcn_sched_barrier(0);
                }
            }
        const int row0 = u.pm * BM + wr * 64 + fr;
#pragma unroll
        for (int ai = 0; ai < 2; ++ai)
#pragma unroll
            for (int m = 0; m < 4; ++m) {
                f32x4 g0, g1;
#pragma unroll
                for (int e = 0; e < 4; ++e) { g0[e] = gelu_tanh(acc[ai][0][m][0][e]) * acc[ai][1][m][0][e]; g1[e] = gelu_tanh(acc[ai][0][m][1][e]) * acc[ai][1][m][1][e]; }
                u32x4 w; w.x = cvt_pk_bf16(g0[0], g0[1]); w.y = cvt_pk_bf16(g0[2], g0[3]); w.z = cvt_pk_bf16(g1[0], g1[1]); w.w = cvt_pk_bf16(g1[2], g1[3]);
                *(u32x4*)(G + (size_t)(row0 + ai * HALF + m * 16) * 3072 + u.pn * 128 + lc0) = w;
                __builtin_amdgcn_sched_barrier(0);
            }
    }
};

template <class Epi, class Sched, bool ALIGN_EPI = false, bool SP2 = false>
__device__ __forceinline__ void gemm_phase(PG8_LAS unsigned char* lds, const Gemm g, const Sched& S, const Epi& E) {
    const int tid = threadIdx.x, wid = __builtin_amdgcn_readfirstlane(tid >> 6), lane = tid & 63, wr = wid >> 2, wc = wid & 3, fr = lane & 15, fq = lane >> 4;
    const int K = g.K, nt = K / BK;
    unsigned voffA[2], voffB[2];
#pragma unroll
    for (int i = 0; i < 2; ++i) { int R, C; stage_rc(tid * 16 + i * 8192, R, C); const int Rb = Epi::PERM ? ((R & ~31) + perm32(R & 31)) : R;
        voffA[i] = (unsigned)(R * K + C) * 2u; voffB[i] = (unsigned)(Rb * K + C) * 2u; }
    const size_t kstep = (size_t)(BK * 2);
    const size_t hstep = (size_t)HALF * K * 2;
    const size_t tstep = 2 * hstep;
    const unsigned ldsw = (unsigned)wid * 1024u;
    const int aoff = lds_byte(wr * 64 + fr, fq * 8), boff = lds_byte(wc * 32 + fr, fq * 8);
#define PG8_SA(b, h) (((b) * 2 + (h)) * HTB)
#define PG8_SB(b, h) ((4 + (b) * 2 + (h)) * HTB)
#define PG8_STAGE(bufoff, gbase, voff) do { _Pragma("unroll") for (int _i = 0; _i < 2; ++_i) \
        __builtin_amdgcn_global_load_lds((const unsigned*)((const char*)(gbase) + (voff)[_i]), (PG8_LAS unsigned*)(lds + (bufoff) + ldsw + _i * 8192), 16, 0, 0); } while (0)
#define PG8_LDA(dst, b, h) do { _Pragma("unroll") for (int m = 0; m < 4; ++m) _Pragma("unroll") for (int k = 0; k < 2; ++k) dst[m][k] = *(const PG8_LAS bf16x8*)(lds + PG8_SA(b, h) + aoff + m * 2048 + k * 1024); } while (0)
#define PG8_LDB(dst, b, h) do { _Pragma("unroll") for (int n = 0; n < 2; ++n) _Pragma("unroll") for (int k = 0; k < 2; ++k) dst[n][k] = *(const PG8_LAS bf16x8*)(lds + PG8_SB(b, h) + boff + n * 2048 + k * 1024); } while (0)
#define PG8_MMA(ai, bj, At, Bt) do { __builtin_amdgcn_s_setprio(1); _Pragma("unroll") for (int m = 0; m < 4; ++m) _Pragma("unroll") for (int n = 0; n < 2; ++n) _Pragma("unroll") for (int k = 0; k < 2; ++k) \
        acc[ai][bj][m][n] = __builtin_amdgcn_mfma_f32_16x16x32_bf16(Bt[n][k], At[m][k], acc[ai][bj][m][n], 0, 0, 0); __builtin_amdgcn_s_setprio(0); } while (0)
#define PG8_WAIT_V(n) asm volatile("s_waitcnt vmcnt(" #n ")" ::: "memory")
#define PG8_WAIT_L(n) asm volatile("s_waitcnt lgkmcnt(" #n ")" ::: "memory")
#define PG8_BAR __builtin_amdgcn_s_barrier()
#define PG8_SCHED __builtin_amdgcn_sched_barrier(0)
    Unit cur, nxt; int ui = 0;
    if (!S.next(0, cur)) return;
    f32x4 acc[2][2][4][2];
#pragma unroll
    for (int a = 0; a < 2; ++a)
#pragma unroll
        for (int b = 0; b < 2; ++b)
#pragma unroll
            for (int m = 0; m < 4; ++m)
#pragma unroll
                for (int n = 0; n < 2; ++n) acc[a][b][m][n] = (f32x4){0.f, 0.f, 0.f, 0.f};
    bf16x8 At[4][2], B0[2][2], B1[2][2];
    const char* cA = (const char*)g.A + (size_t)cur.pm * tstep; const char* cB = (const char*)g.Bt + (size_t)cur.pn * tstep;
    S.a_ready(cur);
    if constexpr (SP2) {
        PG8_STAGE(PG8_SB(0, 0), cB, voffB); PG8_STAGE(PG8_SB(0, 1), cB + hstep, voffB); PG8_STAGE(PG8_SA(0, 0), cA, voffA); PG8_STAGE(PG8_SA(0, 1), cA + hstep, voffA);
        if (wr == 1) PG8_BAR;
        PG8_WAIT_V(2); PG8_BAR;
        PG8_STAGE(PG8_SB(1, 0), cB + kstep, voffB); PG8_STAGE(PG8_SA(1, 0), cA + kstep, voffA); PG8_STAGE(PG8_SB(1, 1), cB + hstep + kstep, voffB);
        PG8_WAIT_V(6); PG8_BAR;
    } else {
        PG8_STAGE(PG8_SB(0, 0), cB, voffB); PG8_STAGE(PG8_SA(0, 0), cA, voffA); PG8_STAGE(PG8_SB(0, 1), cB + hstep, voffB); PG8_STAGE(PG8_SA(0, 1), cA + hstep, voffA);
        if (wr == 1) PG8_BAR;
        PG8_WAIT_V(4); PG8_BAR;
        PG8_STAGE(PG8_SB(1, 0), cB + kstep, voffB); PG8_STAGE(PG8_SA(1, 0), cA + kstep, voffA); PG8_STAGE(PG8_SB(1, 1), cB + hstep + kstep, voffB);
        PG8_WAIT_V(6); PG8_BAR;
    }
    for (;;) {
        const bool has_next = S.next(ui + 1, nxt);
        const char* nA = has_next ? (const char*)g.A + (size_t)nxt.pm * tstep : cA; const char* nB = has_next ? (const char*)g.Bt + (size_t)nxt.pn * tstep : cB;
        for (int t = 0; t < nt; t += 2) {
            const bool last = (t == nt - 2);
            const char* a1 = cA + (size_t)(t + 1) * kstep;
            const char* a2 = last ? nA : cA + (size_t)(t + 2) * kstep; const char* b2 = last ? nB : cB + (size_t)(t + 2) * kstep;
            const char* a3 = a2 + kstep; const char* b3 = b2 + kstep;
            if (last && has_next) S.a_ready(nxt);
            if constexpr (SP2) {
            PG8_LDB(B0, 0, 0); PG8_LDB(B1, 0, 1); PG8_SCHED; PG8_LDA(At, 0, 0); PG8_STAGE(PG8_SA(1, 1), a1 + hstep, voffA);
            PG8_WAIT_V(8); PG8_WAIT_L(0); PG8_BAR; PG8_MMA(0, 0, At, B0); PG8_MMA(0, 1, At, B1); PG8_BAR; PG8_SCHED;
            PG8_LDA(At, 0, 1); PG8_STAGE(PG8_SB(0, 0), b2, voffB); PG8_STAGE(PG8_SB(0, 1), b2 + hstep, voffB); PG8_STAGE(PG8_SA(0, 0), a2, voffA);
            PG8_WAIT_V(8); PG8_WAIT_L(0); PG8_BAR; PG8_MMA(1, 0, At, B0); PG8_MMA(1, 1, At, B1); PG8_BAR; PG8_SCHED;
            PG8_LDB(B0, 1, 0); PG8_LDB(B1, 1, 1); PG8_SCHED; PG8_LDA(At, 1, 0); PG8_STAGE(PG8_SA(0, 1), a2 + hstep, voffA);
            PG8_WAIT_V(8); PG8_WAIT_L(0); PG8_BAR; PG8_MMA(0, 0, At, B0); PG8_MMA(0, 1, At, B1); PG8_BAR; PG8_SCHED;
            PG8_LDA(At, 1, 1); PG8_STAGE(PG8_SB(1, 0), b3, voffB); PG8_STAGE(PG8_SB(1, 1), b3 + hstep, voffB); PG8_STAGE(PG8_SA(1, 0), a3, voffA);
            PG8_WAIT_V(8); PG8_WAIT_L(0); PG8_BAR; PG8_MMA(1, 0, At, B0); PG8_MMA(1, 1, At, B1); PG8_BAR; PG8_SCHED;
            } else {
            PG8_LDB(B0, 0, 0); PG8_SCHED; PG8_LDA(At, 0, 0); PG8_STAGE(PG8_SA(1, 1), a1 + hstep, voffA);
            PG8_WAIT_L(8); PG8_BAR; PG8_WAIT_L(0); PG8_MMA(0, 0, At, B0); PG8_BAR; PG8_SCHED;
            PG8_LDB(B1, 0, 1); PG8_STAGE(PG8_SB(0, 0), b2, voffB);
            PG8_BAR; PG8_WAIT_L(0); PG8_MMA(0, 1, At, B1); PG8_BAR;
            PG8_LDA(At, 0, 1); PG8_STAGE(PG8_SA(0, 0), a2, voffA);
            PG8_BAR; PG8_WAIT_L(0); PG8_MMA(1, 0, At, B0); PG8_BAR; PG8_SCHED;
            PG8_STAGE(PG8_SB(0, 1), b2 + hstep, voffB);
            PG8_WAIT_V(6); PG8_BAR; PG8_MMA(1, 1, At, B1); PG8_BAR;
            PG8_LDB(B0, 1, 0); PG8_SCHED; PG8_LDA(At, 1, 0); PG8_STAGE(PG8_SA(0, 1), a2 + hstep, voffA);
            PG8_WAIT_L(8); PG8_BAR; PG8_WAIT_L(0); PG8_MMA(0, 0, At, B0); PG8_BAR; PG8_SCHED;
            PG8_LDB(B1, 1, 1); PG8_STAGE(PG8_SB(1, 0), b3, voffB);
            PG8_BAR; PG8_WAIT_L(0); PG8_MMA(0, 1, At, B1); PG8_BAR;
            PG8_LDA(At, 1, 1); PG8_STAGE(PG8_SA(1, 0), a3, voffA);
            PG8_BAR; PG8_WAIT_L(0); PG8_MMA(1, 0, At, B0); PG8_BAR; PG8_SCHED;
            PG8_STAGE(PG8_SB(1, 1), b3 + hstep, voffB);
            PG8_WAIT_V(6); PG8_BAR; PG8_MMA(1, 1, At, B1); PG8_BAR;
            }
        }
        if constexpr (ALIGN_EPI) { if (wr == 0) PG8_BAR; }
        if constexpr (!Epi::AFTER_DRAIN) { E(acc, cur, wr, wc, fr, fq); S.done(cur); }
        if (!has_next) break;
#pragma unroll
        for (int a = 0; a < 2; ++a)
#pragma unroll
            for (int b = 0; b < 2; ++b)
#pragma unroll
                for (int m = 0; m < 4; ++m)
#pragma unroll
                    for (int n = 0; n < 2; ++n) acc[a][b][m][n] = (f32x4){0.f, 0.f, 0.f, 0.f};
        cur = nxt; cA = nA; cB = nB; ++ui;
        if constexpr (ALIGN_EPI) { if (wr == 1) PG8_BAR; }
    }
    PG8_WAIT_V(0);
    if constexpr (!ALIGN_EPI) { if (wr == 0) PG8_BAR; }
    PG8_BAR;
    if constexpr (Epi::AFTER_DRAIN) { E.fused(acc, cur, wr, wc, fr, fq, lds, wid, lane); S.done(cur); }
#undef PG8_SA
#undef PG8_SB
#undef PG8_STAGE
#undef PG8_LDA
#undef PG8_LDB
#undef PG8_MMA
#undef PG8_WAIT_V
#undef PG8_WAIT_L
#undef PG8_BAR
#undef PG8_SCHED
}
}

namespace sba {
typedef short bf16x8 __attribute__((ext_vector_type(8)));
typedef short s16x4 __attribute__((ext_vector_type(4)));
typedef float f32x16 __attribute__((ext_vector_type(16)));
typedef unsigned u32x4 __attribute__((ext_vector_type(4)));
typedef unsigned short bf16_t;
constexpr int PITCH = 1024, DH = 128, KVBLK = 64, QB = 256, SEQ_ = 4096;
constexpr int SHM_V = KVBLK * DH * 2, SHM_K = KVBLK * DH * 2;
constexpr int LDS_NEED = 2 * SHM_V + 2 * SHM_K + 64;
#define SBA_KSWZ(row, colB) ((row) * 256 + ((colB) ^ (((row) & 7) << 4)))
#define SBA_SBAR() __builtin_amdgcn_sched_barrier(0)
__device__ __forceinline__ int v_st(int k, int c) { const int kk = (k & ~0xC) | ((k & 4) << 1) | ((k & 8) >> 1); return ((kk >> 3) * 4 + (c >> 5)) * 512 + ((kk & 7) * 32 + (c & 31)) * 2; }
__device__ __forceinline__ int v_rd_base(int lane) { return ((lane & 3) << 3) | (((lane >> 2) & 3) << 6) | (((lane >> 4) & 1) << 5) | (((lane >> 5) & 1) << 8); }
constexpr int v_rd_off(int d0, int ks, int half) { return d0 * 512 + ks * 4096 + half * 2048; }
__device__ __forceinline__ int crow(int r, int hi) { return (r & 3) + 8 * (r >> 2) + 4 * hi; }
__device__ __forceinline__ unsigned cvtpk(float lo, float hi) { unsigned r; asm volatile("v_cvt_pk_bf16_f32 %0, %1, %2" : "=v"(r) : "v"(lo), "v"(hi)); return r; }

template <int KB>
__device__ __forceinline__ void qkt(f32x16& p0, f32x16& p1, const char* K_lds, int r32, int hi, const bf16x8* qr) {
    p0 = f32x16{}; p1 = f32x16{};
    const char* kb[4];
#pragma unroll
    for (int dd = 0; dd < 4; ++dd) kb[dd] = K_lds + KB * SHM_K + SBA_KSWZ(r32, (dd * 16 + hi * 8) * 2);
#pragma unroll
    for (int d0 = 0; d0 < 8; ++d0) { const char* a = kb[d0 & 3] + (d0 >> 2) * 128;
        bf16x8 b0 = *reinterpret_cast<const bf16x8*>(a);
        bf16x8 b1 = *reinterpret_cast<const bf16x8*>(a + 32 * 256);
        p0 = __builtin_amdgcn_mfma_f32_32x32x16_bf16(b0, qr[d0], p0, 0, 0, 0);
        p1 = __builtin_amdgcn_mfma_f32_32x32x16_bf16(b1, qr[d0], p1, 0, 0, 0);
        if (d0 & 1) SBA_SBAR(); }
}
template <int VB>
__device__ __forceinline__ void pv_tile(f32x16* o, int vb0, bf16x8 pa0, bf16x8 pa1, bf16x8 pa2, bf16x8 pa3) {
#define SBA_TRRD(dst, off) asm volatile("ds_read_b64_tr_b16 %0, %1 offset:%2" : "=&v"(dst) : "v"(vb0), "i"(off) : "memory")
#define SBA_PV_D0(d0) do { s16x4 l0, l1, l2, l3, h0, h1, h2, h3; constexpr int b_ = VB * SHM_V + v_rd_off(d0, 0, 0); \
        SBA_TRRD(l0, b_); SBA_TRRD(h0, b_ + 2048); SBA_TRRD(l1, b_ + 4096); SBA_TRRD(h1, b_ + 6144); SBA_TRRD(l2, b_ + 8192); SBA_TRRD(h2, b_ + 10240); SBA_TRRD(l3, b_ + 12288); SBA_TRRD(h3, b_ + 14336); \
        asm volatile("s_waitcnt lgkmcnt(0)" ::: "memory"); SBA_SBAR(); \
        o[d0] = __builtin_amdgcn_mfma_f32_32x32x16_bf16(pa0, (bf16x8){l0[0], l0[1], l0[2], l0[3], h0[0], h0[1], h0[2], h0[3]}, o[d0], 0, 0, 0); \
        o[d0] = __builtin_amdgcn_mfma_f32_32x32x16_bf16(pa1, (bf16x8){l1[0], l1[1], l1[2], l1[3], h1[0], h1[1], h1[2], h1[3]}, o[d0], 0, 0, 0); \
        o[d0] = __builtin_amdgcn_mfma_f32_32x32x16_bf16(pa2, (bf16x8){l2[0], l2[1], l2[2], l2[3], h2[0], h2[1], h2[2], h2[3]}, o[d0], 0, 0, 0); \
        o[d0] = __builtin_amdgcn_mfma_f32_32x32x16_bf16(pa3, (bf16x8){l3[0], l3[1], l3[2], l3[3], h3[0], h3[1], h3[2], h3[3]}, o[d0], 0, 0, 0); } while (0)
    SBA_PV_D0(0); SBA_PV_D0(1); SBA_PV_D0(2); SBA_PV_D0(3);
#undef SBA_PV_D0
#undef SBA_TRRD
}
template <bool MASK>
__device__ __forceinline__ void sb_tile(f32x16& p0, f32x16& p1, int dq  , int hi, float& R, bf16x8& pa0, bf16x8& pa1, bf16x8& pa2, bf16x8& pa3) {
    float T[8];
#pragma unroll
    for (int g = 0; g < 8; ++g) {
        float lb[4], x[4];
#pragma unroll
        for (int i = 0; i < 4; ++i) {
            const int r = (g & 3) * 4 + i; const float z = (g < 4) ? p0[r] : p1[r];
            const float e = __builtin_amdgcn_exp2f(-__builtin_fabsf(z));
            const float l = __builtin_amdgcn_logf(1.0f + e);
            lb[i] = __builtin_fminf(z, 0.f) - l; x[i] = lb[i] - z;
            if (MASK) { const int c = i + 8 * (g & 3) + 32 * (g >> 2); const bool valid = (dq - c) > 0; x[i] = valid ? x[i] : 0.f; lb[i] = valid ? lb[i] : -__builtin_inff(); }
        }
        const float s2 = x[3], s1 = x[3] + x[2], s0 = s1 + x[1];
        T[g] = s0 + x[0];
        lb[0] += s0; lb[1] += s1; lb[2] += s2;
#pragma unroll
        for (int i = 0; i < 4; ++i) { const int r = (g & 3) * 4 + i; if (g < 4) p0[r] = lb[i]; else p1[r] = lb[i]; }
        if (g & 1) SBA_SBAR();
    }
    float run = 0.f, tot = 0.f;
#pragma unroll
    for (int g = 7; g >= 0; --g) {
        const float se = run, si = run + T[g]; run = si;
        auto rr = __builtin_amdgcn_permlane32_swap(__float_as_uint(si), __float_as_uint(se), false, false);
        const float part = hi ? __uint_as_float(rr[0]) : __uint_as_float(rr[1]);
        const float base = se + part + R;
        if (g == 0) { auto r2 = __builtin_amdgcn_permlane32_swap(__float_as_uint(si), __float_as_uint(si), false, false); tot = __uint_as_float(r2[0]) + __uint_as_float(r2[1]); }
#pragma unroll
        for (int i = 0; i < 4; ++i) { const int r = (g & 3) * 4 + i; if (g < 4) p0[r] = __builtin_amdgcn_exp2f(p0[r] + base); else p1[r] = __builtin_amdgcn_exp2f(p1[r] + base); }
        if (!(g & 1)) SBA_SBAR();
    }
    R += tot;
#define SBA_PK4(P, B_, OUT) do { unsigned a0 = cvtpk(P[B_+0], P[B_+1]), a1 = cvtpk(P[B_+2], P[B_+3]); \
        unsigned b0 = cvtpk(P[B_+4], P[B_+5]), b1 = cvtpk(P[B_+6], P[B_+7]); \
        auto r0 = __builtin_amdgcn_permlane32_swap(a0, b0, false, false); auto r1 = __builtin_amdgcn_permlane32_swap(a1, b1, false, false); \
        u32x4 w = {r0[0], r1[0], r0[1], r1[1]}; OUT = *reinterpret_cast<bf16x8*>(&w); } while (0)
    SBA_PK4(p0, 0, pa0); SBA_PK4(p0, 8, pa1); SBA_PK4(p1, 0, pa2); SBA_PK4(p1, 8, pa3);
#undef SBA_PK4
}
template <bool EARLY>
__device__ __forceinline__ void attn_unit(int b, int h, int qb, const bf16_t* Q, const bf16_t* K, const bf16_t* V, bf16_t* O, char* lds) {
    constexpr float RTHR = 160.f;
    typedef __attribute__((address_space(3))) unsigned lds_u32;
    const int tid = threadIdx.x, wid = __builtin_amdgcn_readfirstlane(tid >> 6), lane = tid & 63, r32 = lane & 31, hi = lane >> 5;
    const long rowbase = (long)b * SEQ_; const int q0 = qb * QB;
    const int qlo = q0 + wid * 32, qpos = qlo + r32;
    char* V_lds = lds; char* K_lds = lds + 2 * SHM_V; volatile unsigned* vote = (volatile unsigned*)(lds + 2 * SHM_V + 2 * SHM_K);
    const bf16_t* Qw = Q + (rowbase + qpos) * PITCH + h * DH;
    bf16x8 qr[8];
#pragma unroll
    for (int d0 = 0; d0 < 8; ++d0) qr[d0] = *reinterpret_cast<const bf16x8*>(Qw + d0 * 16 + hi * 8);
    const bf16_t* Kh = K + rowbase * PITCH + h * DH; const bf16_t* Vh = V + rowbase * PITCH + h * DH;
    int kof[2], vof[2];
#pragma unroll
    for (int i = 0; i < 2; ++i) {
        const int row = 8 * wid + 4 * i + (lane >> 4), pos = lane & 15; kof[i] = row * PITCH + ((pos ^ (row & 7)) << 3);
        const int st = 2 * (2 * wid + i) + (lane >> 5), kk = (st >> 2) * 8 + ((lane & 31) >> 2), c = (st & 3) * 32 + (lane & 3) * 8, k = (kk & ~0xC) | ((kk & 4) << 1) | ((kk & 8) >> 1);
        vof[i] = k * PITCH + c; }
    const int vb0 = (int)(uintptr_t)V_lds + v_rd_base(lane);
    lds_u32* const ldsK = (lds_u32*)(uintptr_t)(unsigned)(uintptr_t)(K_lds + wid * 2048);
    lds_u32* const ldsV = (lds_u32*)(uintptr_t)(unsigned)(uintptr_t)(V_lds + wid * 2048);
#define SBA_ISSUE(bf, k0) do { const bf16_t* kp_ = Kh + (size_t)(k0) * PITCH; const bf16_t* vp_ = Vh + (size_t)(k0) * PITCH; \
        __builtin_amdgcn_global_load_lds((const unsigned*)(kp_ + kof[0]), ldsK + ((bf) * SHM_K) / 4, 16, 0, 0); __builtin_amdgcn_global_load_lds((const unsigned*)(kp_ + kof[1]), ldsK + ((bf) * SHM_K + 1024) / 4, 16, 0, 0); \
        __builtin_amdgcn_global_load_lds((const unsigned*)(vp_ + vof[0]), ldsV + ((bf) * SHM_V) / 4, 16, 0, 0); __builtin_amdgcn_global_load_lds((const unsigned*)(vp_ + vof[1]), ldsV + ((bf) * SHM_V + 1024) / 4, 16, 0, 0); } while (0)
    const int NT = (q0 + QB) / KVBLK;
    f32x16 o[4] = {}; float R = 0.f;
    SBA_ISSUE(0, (NT - 1) * KVBLK);
    if (EARLY && tid < 16) vote[tid] = 0u;
    asm volatile("s_waitcnt vmcnt(0)" ::: "memory"); __syncthreads();
#define SBA_STEP(BUF, t) do { const int kb_ = (t) * KVBLK; \
        if ((t) > 0) SBA_ISSUE((BUF) ^ 1, kb_ - KVBLK); \
        if (kb_ <= qlo + 30) {                                     \
            f32x16 p0, p1; bf16x8 pa0, pa1, pa2, pa3; \
            qkt<BUF>(p0, p1, K_lds, r32, hi, qr); \
            sb_tile<true>(p0, p1, (kb_ + KVBLK - 1 >= qlo) ? qpos - kb_ - 4 * hi : (1 << 20), hi, R, pa0, pa1, pa2, pa3);     \
            SBA_SBAR(); pv_tile<BUF>(o, vb0, pa0, pa1, pa2, pa3); } \
        if (EARLY) { const bool done_ = __all(R < -RTHR); if (lane == 0) vote[((t) & 1) * 8 + wid] = done_ ? 1u : 0u; } \
        asm volatile("s_waitcnt vmcnt(0)" ::: "memory"); __syncthreads(); \
    } while (0)
    for (int it = 0; it < NT; it += 2) {
        const int t = NT - 1 - it;
        SBA_STEP(0, t);
        if (EARLY) { unsigned a = 1u; for (int w = 0; w < 8; ++w) a &= vote[(t & 1) * 8 + w]; if (a) break; }
        SBA_STEP(1, t - 1);
        if (EARLY) { unsigned a = 1u; for (int w = 0; w < 8; ++w) a &= vote[((t - 1) & 1) * 8 + w]; if (a) break; }
    }
    bf16_t* Ow = O + (rowbase + qlo) * PITCH + h * DH;
#pragma unroll
    for (int r = 0; r < 16; ++r) { const int orow = crow(r, hi);
#pragma unroll
        for (int d0 = 0; d0 < 4; ++d0) { const float v = o[d0][r]; const float vn = __shfl_xor(v, 1);
            if ((r32 & 1) == 0) *(unsigned*)(Ow + (size_t)orow * PITCH + d0 * 32 + r32) = cvtpk(v, vn); } }
    asm volatile("s_waitcnt vmcnt(0)" ::: "memory"); __syncthreads();
#undef SBA_STEP
#undef SBA_ISSUE
}
#undef SBA_KSWZ
#undef SBA_SBAR
}

#define GAS __attribute__((address_space(1)))
#define LAS __attribute__((address_space(3)))
typedef unsigned short bf16;
typedef unsigned v4u __attribute__((ext_vector_type(4)));
typedef float f32x4 __attribute__((ext_vector_type(4)));
typedef short bf16x8 __attribute__((ext_vector_type(8)));
typedef GAS unsigned gu32;
typedef GAS unsigned long long gu64;
#define RLX_AGENT __ATOMIC_RELAXED, __HIP_MEMORY_SCOPE_AGENT
#define LDS_WAIT() asm volatile("s_waitcnt lgkmcnt(0)" ::: "memory")
#define VM_WAIT() asm volatile("s_waitcnt vmcnt(0)" ::: "memory")
__device__ __forceinline__ unsigned long long rt() { return __builtin_amdgcn_s_memrealtime(); }
__device__ __forceinline__ unsigned f2bf(float f) { unsigned u = __builtin_bit_cast(unsigned, f); return (u + 0x7fffu + ((u >> 16) & 1u)) >> 16; }
__device__ __forceinline__ unsigned pk2(float lo, float hi) { return f2bf(lo) | (f2bf(hi) << 16); }

#define XB_TMO      128
#define XB_XCNT(j)  (256  + 64 * (j))
#define XB_XSUB(j)  (1280 + 64 * (j))
#define XB_XGEN(j)  (2304 + 64 * (j))
#define XB_TOP      3328
#define XB_TOPGEN   3392
#define XCD_BAR_WORDS 3456
#define XB_SPIN_CAP (1u << 18)

__device__ __forceinline__ unsigned xb_ld(unsigned* p)              { return __hip_atomic_load(p, __ATOMIC_RELAXED, __HIP_MEMORY_SCOPE_AGENT); }
__device__ __forceinline__ unsigned xb_add(unsigned* p, unsigned v) { return __hip_atomic_fetch_add(p, v, __ATOMIC_RELAXED, __HIP_MEMORY_SCOPE_AGENT); }
__device__ __forceinline__ unsigned xb_xcc_id() { return (unsigned)__builtin_amdgcn_s_getreg((3 << 11) | 20) & 0xFu; }
#define XB_SPIN(cond, bar) do { unsigned _sp = 0; while (cond) { __builtin_amdgcn_s_sleep(1); \
    if ((++_sp & 255u) == 0u) { if (xb_ld(&(bar)[XB_TMO])) break; if (_sp > XB_SPIN_CAP) { atomicAdd(&(bar)[XB_TMO], 1u); break; } } } } while (0)

struct XcdBarrier {
    unsigned* bar; unsigned x;
    volatile LAS unsigned* st;
};

__device__ __forceinline__ XcdBarrier xcd_barrier_post(unsigned* bar, volatile LAS unsigned* st) {
    XcdBarrier b; b.bar = bar; b.x = xb_xcc_id(); b.st = st;
    if (threadIdx.x == 0) (void)xb_add(&bar[XB_XCNT(b.x)], 1u);
    return b;
}
__device__ __forceinline__ void xcd_barrier_complete(unsigned* bar, unsigned x, unsigned& nloc, unsigned& nx) {
    const unsigned G = gridDim.x * gridDim.y * gridDim.z;
    unsigned sum, cnt, mine, sp = 0u;
    for (;;) {
        sum = 0u; cnt = 0u; mine = 0u;
#pragma unroll
        for (unsigned j = 0; j < 16; ++j) { const unsigned c = xb_ld(&bar[XB_XCNT(j)]); sum += c; cnt += (c > 0u) ? 1u : 0u; mine = (j == x) ? c : mine; }
        if (sum == G) break;
        __builtin_amdgcn_s_sleep(1);
        if ((++sp & 255u) == 0u) { if (xb_ld(&bar[XB_TMO])) break; if (sp > XB_SPIN_CAP) { atomicAdd(&bar[XB_TMO], 1u); break; } }
    }
    nloc = mine > 0u ? mine : 1u; nx = cnt > 0u ? cnt : 1u;
}

__device__ __forceinline__ void xcd_barrier(const XcdBarrier& b) {
    asm volatile("s_waitcnt vmcnt(0)" ::: "memory");
    __syncthreads();
    if (threadIdx.x == 0) {
        unsigned* bar = b.bar;
        __builtin_amdgcn_s_waitcnt(0);
        unsigned nloc = b.st[0], nx = b.st[1];
        if (nloc == 0u) { xcd_barrier_complete(bar, b.x, nloc, nx); b.st[0] = nloc; b.st[1] = nx; }
        const unsigned old = xb_add(&bar[XB_XSUB(b.x)], 1u);
        const unsigned gen = old / nloc;
        if (old + 1u == (gen + 1u) * nloc) {
            __builtin_amdgcn_fence(__ATOMIC_RELEASE, "agent");
            asm volatile("s_waitcnt vmcnt(0)" ::: "memory");
            const unsigned og = xb_add(&bar[XB_TOP], 1u);
            const unsigned tg = og / nx;
            if (og + 1u == (tg + 1u) * nx) xb_add(&bar[XB_TOPGEN], 1u);
            else XB_SPIN(xb_ld(&bar[XB_TOPGEN]) == tg, bar);
            __builtin_amdgcn_fence(__ATOMIC_ACQUIRE, "agent");
            xb_add(&bar[XB_XGEN(b.x)], 1u);
            asm volatile("s_waitcnt vmcnt(0)" ::: "memory");
        } else {
            XB_SPIN(xb_ld(&bar[XB_XGEN(b.x)]) == gen, bar);
            __builtin_amdgcn_fence(__ATOMIC_ACQUIRE, "agent");
            asm volatile("s_waitcnt vmcnt(0)" ::: "memory");
        }
    }
    __syncthreads();
}

constexpr int NWAVES = 8;
constexpr int BATCH = 4, SEQ = 4096, D = 1024, M = BATCH * SEQ, FF = 3072, NH = 8, HD = 128;
constexpr float DN_ALPHA = 1.4142135623730951f;
constexpr float LN_EPS = 1e-5f;
constexpr float QSCALE = 0.08838834764831845f * 1.4426950408889634f;
constexpr size_t MiB = 1u << 20;
constexpr size_t WS_CTL = 0, CTL_ZERO_BYTES = 1 * MiB;
constexpr size_t WS_WIN = 1 * MiB, WS_WOUT = 5 * MiB, WS_WQKV = 7 * MiB, WS_WAO = 13 * MiB, WS_WUP = 15 * MiB, WS_WDN = 39 * MiB, WS_WG = 51 * MiB;
constexpr size_t WS_CSUM = 52 * MiB;
constexpr size_t WS_TSUM = 53 * MiB;
constexpr size_t WS_HPREV = 57 * MiB, WS_HCUR = 60 * MiB;
constexpr size_t WS_XB = 63 * MiB;
constexpr size_t WS_XF = 95 * MiB;
constexpr size_t WS_BIG = 159 * MiB;
constexpr size_t WS_END = 255 * MiB;
constexpr int CW_BAR = 4096;

constexpr int RING_OFF = 0, RING_BYTES = 131072;
constexpr int EXTRA_OFF = RING_BYTES, EXTRA_BYTES = 16384;
constexpr int LDSCTL_OFF = EXTRA_OFF + EXTRA_BYTES, MISC_OFF = LDSCTL_OFF + 320;
constexpr int LDS_BYTES = 151552;
static_assert(MISC_OFF + 128 <= LDS_BYTES, "LDS map");

typedef float f32x16 __attribute__((ext_vector_type(16)));
__device__ __forceinline__ float bf2f(unsigned short b) { return __builtin_bit_cast(float, (unsigned)b << 16); }
__device__ __forceinline__ float wave_sum(float v) {
#pragma unroll
    for (int o = 1; o < 64; o <<= 1) v += __shfl_xor(v, o);
    return v;
}

template <int MAP>
__device__ __forceinline__ void p0_transpose_item(const float* W, int K, int N, bf16* WT, int row_off, LAS float* scr, int item, int lane) {
    const int nblk = N / 32, kb = item / nblk, nb = item % nblk, k0 = 64 * kb, n0 = 32 * nb;
#pragma unroll 8
    for (int i = 0; i < 32; ++i) { const int kk = 2 * i + (lane >> 5); scr[kk * 33 + (lane & 31)] = W[(size_t)(k0 + kk) * N + n0 + (lane & 31)]; }
    LDS_WAIT(); asm volatile("" ::: "memory");
    int r0;
    if (MAP == 0) r0 = row_off + n0; else r0 = (n0 < 3072) ? (256 * (n0 / 128) + (n0 % 128)) : (256 * ((n0 - 3072) / 128) + 128 + ((n0 - 3072) % 128));
    const int c = lane & 7;
#pragma unroll
    for (int j = 0; j < 4; ++j) { const int n = (lane >> 3) + 8 * j; const LAS float* s = scr + (8 * c) * 33 + n;
        v4u o; o.x = pk2(s[0 * 33], s[1 * 33]); o.y = pk2(s[2 * 33], s[3 * 33]); o.z = pk2(s[4 * 33], s[5 * 33]); o.w = pk2(s[6 * 33], s[7 * 33]);
        *(GAS v4u*)(WT + (size_t)(r0 + n) * K + k0 + 8 * c) = o; }
    LDS_WAIT(); asm volatile("" ::: "memory");
}
struct Ptrs {
    const float* in[19]; float* out; unsigned char* ws;
};
__device__ __forceinline__ void p0_prologue(const Ptrs& P, LAS unsigned char* lds, int vcu, int G, int wave, int lane) {
    LAS float* scr = (LAS float*)(lds + RING_OFF + wave * 16384);
    const int gw = vcu * NWAVES + wave, NGW = G * NWAVES;
    unsigned char* ws = P.ws;
    constexpr int I_WIN = 16 * 64, I_SQ = 16 * 32, I_KV = 16 * 64, I_UP = 16 * 192, I_DN = 48 * 32, I_G = 2 * 8;
    constexpr int NITEMS = I_WIN + I_SQ + I_SQ + I_KV + I_SQ + 2 * I_UP + 2 * I_DN + 8 * I_G;
    for (int it = gw; it < NITEMS; it += NGW) {
        int r = it;
        if (r < I_WIN) { p0_transpose_item<0>(P.in[1], 1024, 2048, (bf16*)(ws + WS_WIN), 0, scr, r, lane); continue; } r -= I_WIN;
        if (r < I_SQ) { p0_transpose_item<0>(P.in[8], 1024, 1024, (bf16*)(ws + WS_WOUT), 0, scr, r, lane); continue; } r -= I_SQ;
        if (r < I_SQ) { p0_transpose_item<0>(P.in[11], 1024, 1024, (bf16*)(ws + WS_WQKV), 0, scr, r, lane); continue; } r -= I_SQ;
        if (r < I_KV) { p0_transpose_item<0>(P.in[10], 1024, 2048, (bf16*)(ws + WS_WQKV), 1024, scr, r, lane); continue; } r -= I_KV;
        if (r < I_SQ) { p0_transpose_item<0>(P.in[12], 1024, 1024, (bf16*)(ws + WS_WAO), 0, scr, r, lane); continue; } r -= I_SQ;
        if (r < 2 * I_UP) { const int l = r / I_UP; p0_transpose_item<1>(P.in[13] + (size_t)l * 1024 * 6144, 1024, 6144, (bf16*)(ws + WS_WUP) + (size_t)l * 6144 * 1024, 0, scr, r % I_UP, lane); continue; } r -= 2 * I_UP;
        if (r < 2 * I_DN) { const int l = r / I_DN; p0_transpose_item<0>(P.in[16] + (size_t)l * 3072 * 1024, 3072, 1024, (bf16*)(ws + WS_WDN) + (size_t)l * 1024 * 3072, 0, scr, r % I_DN, lane); continue; } r -= 2 * I_DN;
        { const int n = r / I_G; p0_transpose_item<0>(P.in[5] + (size_t)n * 128 * 256, 128, 256, (bf16*)(ws + WS_WG) + (size_t)n * 256 * 128, 0, scr, r % I_G, lane); }
    }
    const float* x = P.in[0]; bf16* XB = (bf16*)(ws + WS_XB);
    for (int m = gw; m < M; m += NGW) {
        const GAS f32x4* xr = (const GAS f32x4*)(x + (size_t)m * D) + lane;
        GAS unsigned long long* o8 = (GAS unsigned long long*)(XB + (size_t)m * D) + lane;
#pragma unroll
        for (int j = 0; j < 4; ++j) { const f32x4 v = xr[64 * j]; o8[64 * j] = (unsigned long long)pk2(v.x, v.y) | ((unsigned long long)pk2(v.z, v.w) << 32); }
    }
}
__device__ __forceinline__ void ln_pass(float* X, bf16* XB, const float* g, const float* bta, int vcu, int G, int wave, int lane) {
    const int gw = vcu * NWAVES + wave, NGW = G * NWAVES;
    f32x4 gv[4], bv[4];
#pragma unroll
    for (int j = 0; j < 4; ++j) { gv[j] = *((const f32x4*)g + lane + 64 * j); bv[j] = *((const f32x4*)bta + lane + 64 * j); }
    for (int m = gw; m < M; m += NGW) {
        GAS f32x4* xr = (GAS f32x4*)(X + (size_t)m * D) + lane;
        f32x4 v[4]; float s = 0.f;
#pragma unroll
        for (int j = 0; j < 4; ++j) { v[j] = xr[64 * j]; s += (v[j].x + v[j].y) + (v[j].z + v[j].w); }
        const float mean = wave_sum(s) * (1.f / D); float s2 = 0.f;
#pragma unroll
        for (int j = 0; j < 4; ++j) { v[j] = v[j] - mean; s2 += (v[j].x * v[j].x + v[j].y * v[j].y) + (v[j].z * v[j].z + v[j].w * v[j].w); }
        const float rstd = 1.f / sqrtf(wave_sum(s2) * (1.f / D) + LN_EPS);
        GAS unsigned long long* o8 = (GAS unsigned long long*)(XB + (size_t)m * D) + lane;
#pragma unroll
        for (int j = 0; j < 4; ++j) { const f32x4 y = v[j] * rstd * gv[j] + bv[j]; xr[64 * j] = y; o8[64 * j] = (unsigned long long)pk2(y.x, y.y) | ((unsigned long long)pk2(y.z, y.w) << 32); }
    }
}

#define RG_SWZ(row, chunk) ((row) * 256 + ((((chunk) ^ (row)) & 15) << 4))
template <int PASS>
__device__ __forceinline__ void rg_pass(const Ptrs& P, LAS unsigned char* lds, int vcu, int G) {
    const int tid = threadIdx.x, wid = __builtin_amdgcn_readfirstlane(tid >> 6), lane = tid & 63, r32 = lane & 31, hi = lane >> 5;
    unsigned char* ws = P.ws;
    const bf16* XR = (const bf16*)(ws + WS_BIG + 32 * MiB); const bf16* Y = (const bf16*)(ws + WS_BIG); bf16* HY = (bf16*)(ws + WS_BIG + 64 * MiB);
    const bf16* WG = (const bf16*)(ws + WS_WG);
    float* CSUM = (float*)(ws + WS_CSUM); float* TSUM = (float*)(ws + WS_TSUM);
    const float* conv_w = P.in[3]; const float* conv_b = P.in[4]; const float* b_gates = P.in[6]; const float* a_param = P.in[7];
    LAS unsigned char* XBR = lds + RING_OFF;
    LAS unsigned char* WGL = lds + RING_OFF + 65536;
    LAS float* WSUM = (LAS float*)(lds + EXTRA_OFF);
    int cur_n = -1;
    for (int unit = vcu; unit < 512; unit += G) {
        const int n = unit & 7, j = (unit >> 3) & 15, b = unit >> 7;
        const size_t tok0 = (size_t)b * SEQ + (size_t)j * 256;
        __syncthreads();
        if (n != cur_n) { cur_n = n;
#pragma unroll
            for (int it = 0; it < 8; ++it) { const int idx = it * 512 + tid, col = idx >> 4, ch = idx & 15;
                *(LAS v4u*)(WGL + RG_SWZ(col, ch)) = *(const GAS v4u*)(WG + ((size_t)n * 256 + col) * 128 + ch * 8); } }
        { const int cg = tid & 15, rg = tid >> 4, c0 = n * 128 + cg * 8;
            float w[4][8], cbv[8];
#pragma unroll
            for (int k = 0; k < 4; ++k) { const f32x4 a = *(const f32x4*)(conv_w + k * 1024 + c0), bq = *(const f32x4*)(conv_w + k * 1024 + c0 + 4);
                w[k][0] = a.x; w[k][1] = a.y; w[k][2] = a.z; w[k][3] = a.w; w[k][4] = bq.x; w[k][5] = bq.y; w[k][6] = bq.z; w[k][7] = bq.w; }
            { const f32x4 a = *(const f32x4*)(conv_b + c0), bq = *(const f32x4*)(conv_b + c0 + 4); cbv[0] = a.x; cbv[1] = a.y; cbv[2] = a.z; cbv[3] = a.w; cbv[4] = bq.x; cbv[5] = bq.y; cbv[6] = bq.z; cbv[7] = bq.w; }
            bf16x8 xin[11];
#pragma unroll
            for (int i = 0; i < 11; ++i) { const int row = rg * 8 - 3 + i;
                if (row >= 0 || j > 0) xin[i] = *(const GAS bf16x8*)(XR + (tok0 + row) * 1024 + c0); else xin[i] = (bf16x8){0, 0, 0, 0, 0, 0, 0, 0}; }
#pragma unroll
            for (int i = 0; i < 8; ++i) { float y[8];
#pragma unroll
                for (int c = 0; c < 8; ++c) y[c] = cbv[c] + w[0][c] * bf2f((unsigned short)xin[i][c]) + w[1][c] * bf2f((unsigned short)xin[i + 1][c]) + w[2][c] * bf2f((unsigned short)xin[i + 2][c]) + w[3][c] * bf2f((unsigned short)xin[i + 3][c]);
                v4u o; o.x = pk2(y[0], y[1]); o.y = pk2(y[2], y[3]); o.z = pk2(y[4], y[5]); o.w = pk2(y[6], y[7]);
                const int row = rg * 8 + i; *(LAS v4u*)(XBR + RG_SWZ(row, cg)) = o; }
        }
        if (PASS == 2) {
            if (tid < 128) { const int cgl = n * 128 + tid; float C = 0.f;
                for (int jj = 0; jj < j; ++jj) { const float2 s = *(const float2*)(CSUM + (((size_t)b * 16 + jj) * 1024 + cgl) * 2); C = s.x * C + s.y; }
#pragma unroll
                for (int w = 0; w < 8; ++w) { WSUM[w * 128 + tid] = C; const float2 s = *(const float2*)(TSUM + (((size_t)b * 128 + j * 8 + w) * 1024 + cgl) * 2); C = s.x * C + s.y; } }
        }
        __syncthreads();
        bf16x8 af[8];
        { const int row = wid * 32 + r32;
#pragma unroll
            for (int kk = 0; kk < 8; ++kk) af[kk] = *(const LAS bf16x8*)(XBR + RG_SWZ(row, 2 * kk + hi)); }
#pragma unroll 1
        for (int q = 0; q < 4; ++q) {
            const int cl = q * 32 + r32, cgl = n * 128 + cl;
            f32x16 ai = {}, ar = {};
#pragma unroll
            for (int kk = 0; kk < 8; ++kk) {
                const bf16x8 bi = *(const LAS bf16x8*)(WGL + RG_SWZ(cl, 2 * kk + hi)), br = *(const LAS bf16x8*)(WGL + RG_SWZ(128 + cl, 2 * kk + hi));
                ai = __builtin_amdgcn_mfma_f32_32x32x16_bf16(af[kk], bi, ai, 0, 0, 0);
                ar = __builtin_amdgcn_mfma_f32_32x32x16_bf16(af[kk], br, ar, 0, 0, 0); }
            const float bi_ = b_gates[n * 256 + cl], br_ = b_gates[n * 256 + 128 + cl];
            const float spc = 8.0f * log1pf(expf(-a_param[cgl]));
            float yv[16];
            if (PASS == 2) {
#pragma unroll
                for (int r = 0; r < 16; ++r) yv[r] = bf2f(Y[(tok0 + wid * 32 + sba::crow(r, hi)) * 1024 + cgl]);
            }
            float hl[16], pa[16];
#pragma unroll
            for (int r = 0; r < 16; ++r) {
                const int trow = wid * 32 + sba::crow(r, hi);
                const float xb = bf2f(*(const LAS unsigned short*)(XBR + RG_SWZ(trow, cl >> 3) + (cl & 7) * 2));
                const float gi = __builtin_amdgcn_rcpf(1.0f + __expf(-(ai[r] + bi_)));
                const float gr = __builtin_amdgcn_rcpf(1.0f + __expf(-(ar[r] + br_)));
                const float a = __expf(-gr * spc);
                float mult = sqrtf(fmaxf(1.0f - a * a, 0.f));
                if (j == 0 && trow == 0) mult = 1.0f;
                pa[r] = a; hl[r] = mult * gi * xb;
            }
#pragma unroll
            for (int g = 0; g < 4; ++g)
#pragma unroll
                for (int i = 1; i < 4; ++i) { hl[4 * g + i] = pa[4 * g + i] * hl[4 * g + i - 1] + hl[4 * g + i]; pa[4 * g + i] = pa[4 * g + i] * pa[4 * g + i - 1]; }
            float PAb[4], PHb[4];
            float AW = 1.f, HW = 0.f;
#pragma unroll
            for (int g = 0; g < 4; ++g) {
                auto ra = __builtin_amdgcn_permlane32_swap(__float_as_uint(pa[4 * g + 3]), __float_as_uint(pa[4 * g + 3]), false, false);
                auto rh = __builtin_amdgcn_permlane32_swap(__float_as_uint(hl[4 * g + 3]), __float_as_uint(hl[4 * g + 3]), false, false);
                const float Alo = __uint_as_float(ra[0]), Ahi = __uint_as_float(ra[1]), Hlo = __uint_as_float(rh[0]), Hhi = __uint_as_float(rh[1]);
                if (hi == 0) { PAb[g] = AW; PHb[g] = HW; }
                HW = Alo * HW + Hlo; AW = Alo * AW;
                if (hi == 1) { PAb[g] = AW; PHb[g] = HW; }
                HW = Ahi * HW + Hhi; AW = Ahi * AW;
            }
            if (PASS == 1) {
                if (hi == 0) { *(float2*)(TSUM + (((size_t)b * 128 + j * 8 + wid) * 1024 + cgl) * 2) = make_float2(AW, HW); WSUM[(wid * 128 + cl) * 2] = AW; WSUM[(wid * 128 + cl) * 2 + 1] = HW; }
            } else {
                const float C = WSUM[wid * 128 + cl];
#pragma unroll
                for (int g = 0; g < 4; ++g) { const float E = PAb[g] * C + PHb[g];
#pragma unroll
                    for (int i = 0; i < 4; ++i) { const int r = 4 * g + i; const float h = hl[r] + pa[r] * E;
                        HY[(tok0 + wid * 32 + sba::crow(r, hi)) * 1024 + cgl] = (bf16)f2bf(h * yv[r]); } }
            }
        }
        if (PASS == 1) {
            __syncthreads();
            if (tid < 128) { float A = 1.f, H = 0.f;
#pragma unroll
                for (int w = 0; w < 8; ++w) { const float a = WSUM[(w * 128 + tid) * 2], h = WSUM[(w * 128 + tid) * 2 + 1]; H = a * H + h; A = a * A; }
                *(float2*)(CSUM + (((size_t)b * 16 + j) * 1024 + n * 128 + tid) * 2) = make_float2(A, H); }
        }
    }
}
#undef RG_SWZ

__device__ __forceinline__ void ffn_fixup(int pm, bf16* Gb, const float* hprev, const float* hcur, const float* cw, const float* cb) {
    if ((pm & 15) == 0) return;
    const float* pv = hprev + (size_t)(pm - 1) * 2 * 6144; const float* cv = hcur + (size_t)pm * 2 * 6144;
    for (int oc = threadIdx.x; oc < 3072; oc += 512) {
        const int i1 = 256 * (oc >> 7) + (oc & 127), i2 = i1 + 128, c1 = oc, c2 = 3072 + oc;
        const float p0a = pv[i1], p1a = pv[6144 + i1], c0a = cv[i1], c1a = cv[6144 + i1];
        const float p0b = pv[i2], p1b = pv[6144 + i2], c0b = cv[i2], c1b = cv[6144 + i2];
        const float w0a = cw[c1], w1a = cw[6144 + c1], w2a = cw[2 * 6144 + c1], ba = cb[c1];
        const float w0b = cw[c2], w1b = cw[6144 + c2], w2b = cw[2 * 6144 + c2], bb = cb[c2];
        const float y0a = ba + w0a * p0a + w1a * p1a + w2a * c0a, y0b = bb + w0b * p0b + w1b * p1b + w2b * c0b;
        const float y1a = ba + w0a * p1a + w1a * c0a + w2a * c1a, y1b = bb + w0b * p1b + w1b * c0b + w2b * c1b;
        Gb[(size_t)(pm * 256) * 3072 + oc] = (bf16)f2bf(pg8::gelu_tanh(y0a) * y0b);
        Gb[(size_t)(pm * 256 + 1) * 3072 + oc] = (bf16)f2bf(pg8::gelu_tanh(y1a) * y1b);
    }
}

#ifndef MK_PER_PHASE
#define MK_PER_PHASE 0
#endif
constexpr int N_PHASES = 16;
struct Args { const float* in[19]; float* out; unsigned char* ws; int ph_lo, ph_hi, li, pad; };
__global__ void __launch_bounds__(NWAVES * 64, 2) yoco_fwd(Args args) {
    extern __shared__ __attribute__((aligned(16))) unsigned char lds_raw[];
    LAS unsigned char* lds = (LAS unsigned char*)lds_raw;
    volatile LAS unsigned* MISC = (volatile LAS unsigned*)(lds + MISC_OFF);
    const int tid = threadIdx.x, lane = tid & 63, wave = __builtin_amdgcn_readfirstlane(tid >> 6);
    const int G = gridDim.x; const int bx = blockIdx.x; const int vcu = (G % 8 == 0) ? (bx % 8) * (G / 8) + bx / 8 : bx;
    unsigned char* ws = args.ws;
    gu32* ctl = (gu32*)(ws + WS_CTL);
    Ptrs P; for (int i = 0; i < 19; ++i) P.in[i] = args.in[i]; P.out = args.out; P.ws = ws;
    for (int u = tid; u < (LDS_BYTES - LDSCTL_OFF) / 4; u += NWAVES * 64) ((LAS unsigned*)(lds + LDSCTL_OFF))[u] = 0u;
    __syncthreads();
    XcdBarrier bar; bar.bar = (unsigned*)(ctl + CW_BAR); bar.x = 0; bar.st = nullptr;
    if (!MK_PER_PHASE) bar = xcd_barrier_post((unsigned*)(ctl + CW_BAR), MISC + 8);
    const int lo = args.ph_lo, hi_ = args.ph_hi;
#ifndef PHMASK
#define PHMASK 0xFFFF
#endif
#define IN(k) ((((PHMASK) >> (k)) & 1) && lo <= (k) && (k) < hi_)
#define SEAM(k) do { if (IN(k) && IN((k) + 1)) xcd_barrier(bar); } while (0)
    bf16* XB = (bf16*)(ws + WS_XB); float* XF = (float*)(ws + WS_XF);
    bf16* BIG = (bf16*)(ws + WS_BIG);
    bf16* Yb = BIG; bf16* XRb = (bf16*)(ws + WS_BIG + 32 * MiB); bf16* HYb = (bf16*)(ws + WS_BIG + 64 * MiB);
    bf16* Qb = BIG; bf16* Kb = XRb; bf16* Vb = HYb;
    float* HPREV = (float*)(ws + WS_HPREV); float* HCUR = (float*)(ws + WS_HCUR);
    const float* ln_g = P.in[17]; const float* ln_b = P.in[18];

    if (IN(0)) { p0_prologue(P, lds, vcu, G, wave, lane); } SEAM(0);
    if (IN(1)) { pg8::Gemm g{XB, (const bf16*)(ws + WS_WIN), M, 2048, D}; pg8::StaticOrder S; S.init(M, 2048, G, bx);
        pg8::EpiG1 E{Yb, XRb, P.in[2]}; pg8::gemm_phase<pg8::EpiG1, pg8::StaticOrder, true, true>(lds + RING_OFF, g, S, E); } SEAM(1);
    if (IN(2)) { rg_pass<1>(P, lds, vcu, G); } SEAM(2);
    if (IN(3)) { rg_pass<2>(P, lds, vcu, G); } SEAM(3);
    if (IN(4)) { pg8::Gemm g{HYb, (const bf16*)(ws + WS_WOUT), M, D, D}; pg8::StaticOrder S; S.init(M, D, G, bx);
        pg8::EpiSum E{P.in[0], XF, P.in[9], DN_ALPHA}; pg8::gemm_phase<pg8::EpiSum, pg8::StaticOrder, true, true>(lds + RING_OFF, g, S, E); } SEAM(4);
    if (IN(5)) { ln_pass(XF, XB, ln_g + 0 * D, ln_b + 0 * D, vcu, G, wave, lane); } SEAM(5);
    if (IN(6)) { pg8::Gemm g{XB, (const bf16*)(ws + WS_WUP), M, 2 * FF, D}; pg8::StaticOrder S; S.init(M, 2 * FF, G, bx);
        pg8::EpiFfnUp E{BIG, P.in[14], P.in[15], HPREV, HCUR, (LAS float*)(lds + EXTRA_OFF)}; pg8::gemm_phase<pg8::EpiFfnUp, pg8::StaticOrder, true, true>(lds + RING_OFF, g, S, E); } SEAM(6);
    if (IN(7)) { pg8::Gemm g{BIG, (const bf16*)(ws + WS_WDN), M, D, FF}; pg8::StaticOrder S; S.init(M, D, G, bx);
        { pg8::Unit u; for (int i = 0; S.next(i, u); ++i) ffn_fixup(u.pm, BIG, HPREV, HCUR, P.in[14], P.in[15]); VM_WAIT(); __syncthreads(); }
        pg8::EpiSum E{XF, P.out, nullptr, DN_ALPHA}; pg8::gemm_phase<pg8::EpiSum, pg8::StaticOrder, true, true>(lds + RING_OFF, g, S, E); } SEAM(7);
    if (IN(8)) { ln_pass(P.out, XB, ln_g + 1 * D, ln_b + 1 * D, vcu, G, wave, lane); } SEAM(8);
    if (IN(9)) { pg8::Gemm g{XB, (const bf16*)(ws + WS_WQKV), M, 3 * D, D}; pg8::StaticOrder S; S.init(M, 3 * D, G, bx);
        pg8::EpiBf16S E{Qb, D, D, (size_t)(16 * MiB), QSCALE}; pg8::gemm_phase<pg8::EpiBf16S, pg8::StaticOrder, true, true>(lds + RING_OFF, g, S, E); } SEAM(9);
    if (IN(10)) {
        for (int u = vcu; u < 512; u += G) { const int v = u & 255, pass = u >> 8, bh = v >> 3, s = v & 7, qb = pass ? 15 - s : s;
            sba::attn_unit<false>(bh >> 3, bh & 7, qb, Qb, Kb, Vb, Qb, (char*)lds_raw + RING_OFF); }
    } SEAM(10);
    if (IN(11)) { pg8::Gemm g{Qb, (const bf16*)(ws + WS_WAO), M, D, D}; pg8::StaticOrder S; S.init(M, D, G, bx);
        pg8::EpiSum E{P.out, XF, nullptr, DN_ALPHA}; pg8::gemm_phase<pg8::EpiSum, pg8::StaticOrder, true, true>(lds + RING_OFF, g, S, E); } SEAM(11);
    if (IN(12)) { ln_pass(XF, XB, ln_g + 2 * D, ln_b + 2 * D, vcu, G, wave, lane); } SEAM(12);
    if (IN(13)) { pg8::Gemm g{XB, (const bf16*)(ws + WS_WUP) + (size_t)6144 * 1024, M, 2 * FF, D}; pg8::StaticOrder S; S.init(M, 2 * FF, G, bx);
        pg8::EpiFfnUp E{BIG, P.in[14] + 3 * 6144, P.in[15] + 6144, HPREV, HCUR, (LAS float*)(lds + EXTRA_OFF)}; pg8::gemm_phase<pg8::EpiFfnUp, pg8::StaticOrder, true, true>(lds + RING_OFF, g, S, E); } SEAM(13);
    if (IN(14)) { pg8::Gemm g{BIG, (const bf16*)(ws + WS_WDN) + (size_t)1024 * 3072, M, D, FF}; pg8::StaticOrder S; S.init(M, D, G, bx);
        { pg8::Unit u; for (int i = 0; S.next(i, u); ++i) ffn_fixup(u.pm, BIG, HPREV, HCUR, P.in[14] + 3 * 6144, P.in[15] + 6144); VM_WAIT(); __syncthreads(); }
        pg8::EpiSum E{XF, P.out, nullptr, DN_ALPHA}; pg8::gemm_phase<pg8::EpiSum, pg8::StaticOrder, true, true>(lds + RING_OFF, g, S, E); } SEAM(14);
    if (IN(15)) { ln_pass(P.out, XB, ln_g + 3 * D, ln_b + 3 * D, vcu, G, wave, lane); }
#undef IN
#undef SEAM
}

extern "C" void kernel_launch(void* const* d_in, const int* in_sizes, int n_in, void* d_out, int out_size, void* d_ws, size_t ws_size, hipStream_t stream) {
    static int grid = 0;
    if (grid == 0) {
        if (n_in != 19 || in_sizes[0] != M * D || out_size != M * D || ws_size < WS_END) { fprintf(stderr, "kernel_launch: unexpected shapes (n_in %d, in0 %d, out %d, ws %zu)\n", n_in, n_in > 0 ? in_sizes[0] : -1, out_size, ws_size); grid = -1; return; }
        int dev = 0, cus = 0, per_cu = 0;
        if (hipGetDevice(&dev) != hipSuccess || hipDeviceGetAttribute(&cus, hipDeviceAttributeMultiprocessorCount, dev) != hipSuccess) { grid = -1; return; }
        if (hipFuncSetAttribute((const void*)yoco_fwd, hipFuncAttributeMaxDynamicSharedMemorySize, LDS_BYTES) != hipSuccess) { fprintf(stderr, "kernel_launch: hipFuncSetAttribute failed\n"); grid = -1; return; }
        if (hipOccupancyMaxActiveBlocksPerMultiprocessor(&per_cu, (const void*)yoco_fwd, NWAVES * 64, LDS_BYTES) != hipSuccess || per_cu < 1) { fprintf(stderr, "kernel_launch: occupancy query says %d blocks per CU\n", per_cu); per_cu = 1; }
        (void)hipGetLastError();
        grid = cus;
    }
    if (grid < 0) return;
    (void)hipMemsetAsync((char*)d_ws + WS_CTL, 0, CTL_ZERO_BYTES, stream);
    Args a{};
    for (int i = 0; i < 19; ++i) a.in[i] = (const float*)d_in[i];
    a.out = (float*)d_out; a.ws = (unsigned char*)d_ws;
#if MK_PER_PHASE
    for (int p = 0; p < N_PHASES; ++p) { a.ph_lo = p; a.ph_hi = p + 1; a.li = p; hipLaunchKernelGGL(yoco_fwd, dim3(grid), dim3(NWAVES * 64), LDS_BYTES, stream, a); }
#else
    a.ph_lo = 0; a.ph_hi = N_PHASES; a.li = 0;
    hipLaunchKernelGGL(yoco_fwd, dim3(grid), dim3(NWAVES * 64), LDS_BYTES, stream, a);
#endif
}
```

```cpp
#include <hip/hip_runtime.h>
#include <hip/hip_bf16.h>
#include <cstdio>
#include <cstdint>
namespace pg8 {
#define PG8_LAS __attribute__((address_space(3)))
typedef unsigned short bf16_t;
typedef short bf16x8 __attribute__((ext_vector_type(8)));
typedef float f32x4 __attribute__((ext_vector_type(4)));
typedef unsigned u32x4 __attribute__((ext_vector_type(4)));
constexpr int BM = 256, BK = 64, HALF = 128, HTB = HALF * BK * 2  , STAGE_BYTES = 8 * HTB, NXCD = 8, WGM = 8;

__host__ __device__ __forceinline__ int lds_byte(int r, int c) { const int st = (r >> 4) * 2 + (c >> 5), rr = r & 15, cc = c & 31, ob = rr * 64 + cc * 2; return st * 1024 + (ob ^ (((ob >> 9) & 1) << 5)); }
__host__ __device__ __forceinline__ void stage_rc(int b, int& R, int& C) { const int st = b / 1024, sb = b % 1024, swz = sb ^ (((sb >> 9) & 1) << 5); R = (st >> 1) * 16 + swz / 64; C = (st & 1) * 32 + (swz % 64) / 2; }
__host__ __device__ __forceinline__ int perm32(int rho) { const int n = rho >> 4, i = rho & 15; return 8 * (i >> 2) + 4 * n + (i & 3); }

struct Unit { int pm, pn; };
struct Gemm { const bf16_t* A; const bf16_t* Bt; int M, N, K; };

struct StaticOrder {
    int nM, nN, nwg, G, c;
    __host__ __device__ void init(int M, int N, int G_, int c_) { nM = M / BM; nN = N / BM; nwg = nM * nN; G = G_; c = c_; }
    __host__ __device__ bool next(int i, Unit& u) const {
        const long L = (long)i * G + c; if (L >= nwg) return false;
        int wgid = (int)L; { const int q = nwg / NXCD, r = nwg % NXCD, xcd = wgid % NXCD, off = wgid / NXCD; wgid = (xcd < r ? xcd * (q + 1) : r * (q + 1) + (xcd - r) * q) + off; }
        const int nig = WGM * nN, gid = wgid / nig, fm = gid * WGM, gsz = (nM - fm) < WGM ? (nM - fm) : WGM;
        u.pm = fm + ((wgid % nig) % gsz); u.pn = (wgid % nig) / gsz; return true;
    }
    __device__ __forceinline__ void a_ready(const Unit&) const {}
    __device__ __forceinline__ void done(const Unit&) const {}
};

__device__ __forceinline__ unsigned cvt_pk_bf16(float lo, float hi) { unsigned r; asm volatile("v_cvt_pk_bf16_f32 %0, %1, %2" : "=v"(r) : "v"(lo), "v"(hi)); return r; }
typedef float f32x2 __attribute__((ext_vector_type(2)));

__device__ __forceinline__ float gelu_tanh(float v) {
    const float k2 = -2.0f * 0.7978845608028654f * 1.4426950408889634f;
    const float uu = v * (1.0f + 0.044715f * v * v);
    const float e = __builtin_amdgcn_exp2f(k2 * uu);
    return v * __builtin_amdgcn_rcpf(1.0f + e);
}
struct EpiBf16S {
    static constexpr bool PERM = true, AFTER_DRAIN = false;
    bf16_t* O; int ldc; int split_cols; size_t split_stride; float scale0;
    __device__ __forceinline__ void operator()(const f32x4 (&acc)[2][2][4][2], const Unit& u, int wr, int wc, int fr, int fq) const {
        const int row0 = u.pm * BM + wr * 64 + fr; int colt = u.pn * BM; bf16_t* base = O;
        float sc = 1.f; { const int t = colt / split_cols; base += (size_t)t * split_stride; colt -= t * split_cols; if (t == 0) sc = scale0; }
        const int col0 = colt + wc * 32 + 8 * fq;
#pragma unroll
        for (int ai = 0; ai < 2; ++ai)
#pragma unroll
            for (int m = 0; m < 4; ++m) { bf16_t* rowp = base + (size_t)(row0 + ai * HALF + m * 16) * ldc + col0;
#pragma unroll
                for (int bj = 0; bj < 2; ++bj) { f32x4 v0 = acc[ai][bj][m][0] * sc, v1 = acc[ai][bj][m][1] * sc;
                    u32x4 w; w.x = cvt_pk_bf16(v0[0], v0[1]); w.y = cvt_pk_bf16(v0[2], v0[3]); w.z = cvt_pk_bf16(v1[0], v1[1]); w.w = cvt_pk_bf16(v1[2], v1[3]);
                    *(u32x4*)(rowp + bj * HALF) = w; } }
    }
};
struct EpiG1 {
    static constexpr bool PERM = true, AFTER_DRAIN = false;
    bf16_t* Y; bf16_t* XR; const float* bias;
    __device__ __forceinline__ void operator()(const f32x4 (&acc)[2][2][4][2], const Unit& u, int wr, int wc, int fr, int fq) const {
        const int row0 = u.pm * BM + wr * 64 + fr; const int colt = u.pn * BM; const bool isY = colt < 1024;
        bf16_t* base = isY ? Y : XR; const int col0 = (isY ? colt : colt - 1024) + wc * 32 + 8 * fq, bcol0 = colt + wc * 32 + 8 * fq;
        f32x4 bv[2][2];
#pragma unroll
        for (int bj = 0; bj < 2; ++bj)
#pragma unroll
            for (int n = 0; n < 2; ++n) bv[bj][n] = *(const f32x4*)(bias + bcol0 + bj * HALF + 4 * n);
#pragma unroll
        for (int ai = 0; ai < 2; ++ai)
#pragma unroll
            for (int m = 0; m < 4; ++m) { bf16_t* rowp = base + (size_t)(row0 + ai * HALF + m * 16) * 1024 + col0;
#pragma unroll
                for (int bj = 0; bj < 2; ++bj) { f32x4 v0 = acc[ai][bj][m][0] + bv[bj][0], v1 = acc[ai][bj][m][1] + bv[bj][1];
                    if (isY) {
#pragma unroll
                        for (int e = 0; e < 4; ++e) { v0[e] = gelu_tanh(v0[e]); v1[e] = gelu_tanh(v1[e]); } }
                    u32x4 w; w.x = cvt_pk_bf16(v0[0], v0[1]); w.y = cvt_pk_bf16(v0[2], v0[3]); w.z = cvt_pk_bf16(v1[0], v1[1]); w.w = cvt_pk_bf16(v1[2], v1[3]);
                    *(u32x4*)(rowp + bj * HALF) = w; } }
    }
};
struct EpiSum {
    static constexpr bool PERM = false, AFTER_DRAIN = false;
    const float* res; float* out; const float* bias; float alpha;
    __device__ __forceinline__ void operator()(const f32x4 (&acc)[2][2][4][2], const Unit& u, int wr, int wc, int fr, int fq) const {
        const int col0 = u.pn * BM + wc * 32 + 4 * fq;
        f32x4 bv[2][2];
#pragma unroll
        for (int bj = 0; bj < 2; ++bj)
#pragma unroll
            for (int n = 0; n < 2; ++n) bv[bj][n] = bias ? *(const f32x4*)(bias + col0 + bj * HALF + n * 16) : (f32x4){0.f, 0.f, 0.f, 0.f};
#pragma unroll
        for (int ai = 0; ai < 2; ++ai)
#pragma unroll
            for (int m = 0; m < 4; ++m) { const size_t off = (size_t)(u.pm * BM + ai * HALF + wr * 64 + m * 16 + fr) * 1024 + col0;
#pragma unroll
                for (int bj = 0; bj < 2; ++bj)
#pragma unroll
                    for (int n = 0; n < 2; ++n) { const f32x4 r = *(const f32x4*)(res + off + bj * HALF + n * 16);
                        *(f32x4*)(out + off + bj * HALF + n * 16) = r * alpha + acc[ai][bj][m][n] + bv[bj][n]; } }
    }
};
__device__ __forceinline__ float dpp_shr1(float old, float src) { return __builtin_bit_cast(float, __builtin_amdgcn_update_dpp(__builtin_bit_cast(int, old), __builtin_bit_cast(int, src), 0x111, 0xf, 0xf, false)); }
__device__ __forceinline__ float dpp_shr2(float old, float src) { return __builtin_bit_cast(float, __builtin_amdgcn_update_dpp(__builtin_bit_cast(int, old), __builtin_bit_cast(int, src), 0x112, 0xf, 0xf, false)); }
__device__ __forceinline__ float dpp_ror1(float src) { return __builtin_bit_cast(float, __builtin_amdgcn_update_dpp(0, __builtin_bit_cast(int, src), 0x121, 0xf, 0xf, false)); }
__device__ __forceinline__ float dpp_ror2(float src) { return __builtin_bit_cast(float, __builtin_amdgcn_update_dpp(0, __builtin_bit_cast(int, src), 0x122, 0xf, 0xf, false)); }
struct EpiFfnUp {
    static constexpr bool PERM = true, AFTER_DRAIN = false;
    bf16_t* G; const float* cw; const float* cb; float* halo_prev; float* halo_cur; PG8_LAS float* scr;
    __device__ __forceinline__ void operator()(f32x4 (&acc)[2][2][4][2], const Unit& u, int wr, int wc, int fr_, int fq) const {
        int lc0 = wc * 32 + 8 * fq, fr = fr_;
        asm volatile("" : "+v"(lc0), "+v"(fr));
        if (fr >= 14) {
#pragma unroll
            for (int ai = 0; ai < 2; ++ai)
#pragma unroll
                for (int bj = 0; bj < 2; ++bj)
#pragma unroll
                    for (int n = 0; n < 2; ++n) {
                        *(PG8_LAS f32x4*)(scr + (((ai * 2 + wr) * 2 + (fr - 14)) * 256 + bj * 128 + lc0 + 4 * n)) = acc[ai][bj][3][n];
                        if (ai == 1 && wr == 1) *(f32x4*)(halo_prev + ((size_t)(u.pm * 2 + (fr - 14)) * 6144 + u.pn * 256 + bj * 128 + lc0 + 4 * n)) = acc[1][bj][3][n];
                    }
        }
        if (fr < 2 && wr == 0) {
#pragma unroll
            for (int bj = 0; bj < 2; ++bj)
#pragma unroll
                for (int n = 0; n < 2; ++n) *(f32x4*)(halo_cur + ((size_t)(u.pm * 2 + fr) * 6144 + u.pn * 256 + bj * 128 + lc0 + 4 * n)) = acc[0][bj][0][n];
        }
        asm volatile("s_waitcnt lgkmcnt(0)" ::: "memory"); __builtin_amdgcn_s_barrier(); asm volatile("" ::: "memory");
#pragma unroll
        for (int bj = 0; bj < 2; ++bj)
#pragma unroll
            for (int n = 0; n < 2; ++n) {
                const int gc = bj * 3072 + u.pn * 128 + lc0 + 4 * n;
                const f32x4 w0 = *(const f32x4*)(cw + gc), w1 = *(const f32x4*)(cw + 6144 + gc), w2 = *(const f32x4*)(cw + 2 * 6144 + gc), bb = *(const f32x4*)(cb + gc);
#pragma unroll
                for (int ai = 1; ai >= 0; --ai) {
                    f32x4 p62, p63;
                    const int grp = ai * 2 + wr;
                    { const int gp = grp > 0 ? grp - 1 : 0; const bool keep = grp > 0; const f32x4 zz = {0.f, 0.f, 0.f, 0.f};
                      p62 = *(const PG8_LAS f32x4*)(scr + ((gp * 2 + 0) * 256 + bj * 128 + lc0 + 4 * n)); p63 = *(const PG8_LAS f32x4*)(scr + ((gp * 2 + 1) * 256 + bj * 128 + lc0 + 4 * n)); p62 = keep ? p62 : zz; p63 = keep ? p63 : zz; }
#pragma unroll
                    for (int m = 3; m >= 0; --m) {
                        const f32x4 cur = acc[ai][bj][m][n]; f32x4 y;
#pragma unroll
                        for (int e = 0; e < 4; ++e) {
                            float t1, t2;
                            if (m > 0) { t1 = dpp_ror1(acc[ai][bj][m - 1][n][e]); t2 = dpp_ror2(acc[ai][bj][m - 1][n][e]); }
                            else { t1 = p63[e]; t2 = (fr == 0) ? p62[e] : p63[e]; }
                            const float q1 = dpp_shr1(t1, cur[e]), q2 = dpp_shr2(t2, cur[e]);
                            y[e] = bb[e] + w2[e] * cur[e] + w1[e] * q1 + w0[e] * q2;
                        }
                        asm volatile("" : "+v"(y));
                        acc[ai][bj][m][n] = y;
                    }
                    asm volatile("" ::: "memory"); __builtin_amdgcn_sched_barrier(0);
                }
            }
        const int row0 = u.pm * BM + wr * 64 + fr;
#pragma unroll
        for (int ai = 0; ai < 2; ++ai)
#pragma unroll
            for (int m = 0; m < 4; ++m) {
                f32x4 g0, g1;
#pragma unroll
                for (int e = 0; e < 4; ++e) { g0[e] = gelu_tanh(acc[ai][0][m][0][e]) * acc[ai][1][m][0][e]; g1[e] = gelu_tanh(acc[ai][0][m][1][e]) * acc[ai][1][m][1][e]; }
                u32x4 w; w.x = cvt_pk_bf16(g0[0], g0[1]); w.y = cvt_pk_bf16(g0[2], g0[3]); w.z = cvt_pk_bf16(g1[0], g1[1]); w.w = cvt_pk_bf16(g1[2], g1[3]);
                *(u32x4*)(G + (size_t)(row0 + ai * HALF + m * 16) * 3072 + u.pn * 128 + lc0) = w;
                __builtin_amdgcn_sched_barrier(0);
            }
    }
};

template <class Epi, class Sched, bool ALIGN_EPI = false, bool SP2 = false>
__device__ __forceinline__ void gemm_phase(PG8_LAS unsigned char* lds, const Gemm g, const Sched& S, const Epi& E) {
    const int tid = threadIdx.x, wid = __builtin_amdgcn_readfirstlane(tid >> 6), lane = tid & 63, wr = wid >> 2, wc = wid & 3, fr = lane & 15, fq = lane >> 4;
    const int K = g.K, nt = K / BK;
    unsigned voffA[2], voffB[2];
#pragma unroll
    for (int i = 0; i < 2; ++i) { int R, C; stage_rc(tid * 16 + i * 8192, R, C); const int Rb = Epi::PERM ? ((R & ~31) + perm32(R & 31)) : R;
        voffA[i] = (unsigned)(R * K + C) * 2u; voffB[i] = (unsigned)(Rb * K + C) * 2u; }
    const size_t kstep = (size_t)(BK * 2);
    const size_t hstep = (size_t)HALF * K * 2;
    const size_t tstep = 2 * hstep;
    const unsigned ldsw = (unsigned)wid * 1024u;
    const int aoff = lds_byte(wr * 64 + fr, fq * 8), boff = lds_byte(wc * 32 + fr, fq * 8);
#define PG8_SA(b, h) (((b) * 2 + (h)) * HTB)
#define PG8_SB(b, h) ((4 + (b) * 2 + (h)) * HTB)
#define PG8_STAGE(bufoff, gbase, voff) do { _Pragma("unroll") for (int _i = 0; _i < 2; ++_i) \
        __builtin_amdgcn_global_load_lds((const unsigned*)((const char*)(gbase) + (voff)[_i]), (PG8_LAS unsigned*)(lds + (bufoff) + ldsw + _i * 8192), 16, 0, 0); } while (0)
#define PG8_LDA(dst, b, h) do { _Pragma("unroll") for (int m = 0; m < 4; ++m) _Pragma("unroll") for (int k = 0; k < 2; ++k) dst[m][k] = *(const PG8_LAS bf16x8*)(lds + PG8_SA(b, h) + aoff + m * 2048 + k * 1024); } while (0)
#define PG8_LDB(dst, b, h) do { _Pragma("unroll") for (int n = 0; n < 2; ++n) _Pragma("unroll") for (int k = 0; k < 2; ++k) dst[n][k] = *(const PG8_LAS bf16x8*)(lds + PG8_SB(b, h) + boff + n * 2048 + k * 1024); } while (0)
#define PG8_MMA(ai, bj, At, Bt) do { __builtin_amdgcn_s_setprio(1); _Pragma("unroll") for (int m = 0; m < 4; ++m) _Pragma("unroll") for (int n = 0; n < 2; ++n) _Pragma("unroll") for (int k = 0; k < 2; ++k) \
        acc[ai][bj][m][n] = __builtin_amdgcn_mfma_f32_16x16x32_bf16(Bt[n][k], At[m][k], acc[ai][bj][m][n], 0, 0, 0); __builtin_amdgcn_s_setprio(0); } while (0)
#define PG8_WAIT_V(n) asm volatile("s_waitcnt vmcnt(" #n ")" ::: "memory")
#define PG8_WAIT_L(n) asm volatile("s_waitcnt lgkmcnt(" #n ")" ::: "memory")
#define PG8_BAR __builtin_amdgcn_s_barrier()
#define PG8_SCHED __builtin_amdgcn_sched_barrier(0)
    Unit cur, nxt; int ui = 0;
    if (!S.next(0, cur)) return;
    f32x4 acc[2][2][4][2];
#pragma unroll
    for (int a = 0; a < 2; ++a)
#pragma unroll
        for (int b = 0; b < 2; ++b)
#pragma unroll
            for (int m = 0; m < 4; ++m)
#pragma unroll
                for (int n = 0; n < 2; ++n) acc[a][b][m][n] = (f32x4){0.f, 0.f, 0.f, 0.f};
    bf16x8 At[4][2], B0[2][2], B1[2][2];
    const char* cA = (const char*)g.A + (size_t)cur.pm * tstep; const char* cB = (const char*)g.Bt + (size_t)cur.pn * tstep;
    S.a_ready(cur);
    if constexpr (SP2) {
        PG8_STAGE(PG8_SB(0, 0), cB, voffB); PG8_STAGE(PG8_SB(0, 1), cB + hstep, voffB); PG8_STAGE(PG8_SA(0, 0), cA, voffA); PG8_STAGE(PG8_SA(0, 1), cA + hstep, voffA);
        if (wr == 1) PG8_BAR;
        PG8_WAIT_V(2); PG8_BAR;
        PG8_STAGE(PG8_SB(1, 0), cB + kstep, voffB); PG8_STAGE(PG8_SA(1, 0), cA + kstep, voffA); PG8_STAGE(PG8_SB(1, 1), cB + hstep + kstep, voffB);
        PG8_WAIT_V(6); PG8_BAR;
    } else {
        PG8_STAGE(PG8_SB(0, 0), cB, voffB); PG8_STAGE(PG8_SA(0, 0), cA, voffA); PG8_STAGE(PG8_SB(0, 1), cB + hstep, voffB); PG8_STAGE(PG8_SA(0, 1), cA + hstep, voffA);
        if (wr == 1) PG8_BAR;
        PG8_WAIT_V(4); PG8_BAR;
        PG8_STAGE(PG8_SB(1, 0), cB + kstep, voffB); PG8_STAGE(PG8_SA(1, 0), cA + kstep, voffA); PG8_STAGE(PG8_SB(1, 1), cB + hstep + kstep, voffB);
        PG8_WAIT_V(6); PG8_BAR;
    }
    for (;;) {
        const bool has_next = S.next(ui + 1, nxt);
        const char* nA = has_next ? (const char*)g.A + (size_t)nxt.pm * tstep : cA; const char* nB = has_next ? (const char*)g.Bt + (size_t)nxt.pn * tstep : cB;
        for (int t = 0; t < nt; t += 2) {
            const bool last = (t == nt - 2);
            const char* a1 = cA + (size_t)(t + 1) * kstep;
            const char* a2 = last ? nA : cA + (size_t)(t + 2) * kstep; const char* b2 = last ? nB : cB + (size_t)(t + 2) * kstep;
            const char* a3 = a2 + kstep; const char* b3 = b2 + kstep;
            if (last && has_next) S.a_ready(nxt);
            if constexpr (SP2) {
            PG8_LDB(B0, 0, 0); PG8_LDB(B1, 0, 1); PG8_SCHED; PG8_LDA(At, 0, 0); PG8_STAGE(PG8_SA(1, 1), a1 + hstep, voffA);
            PG8_WAIT_V(8); PG8_WAIT_L(0); PG8_BAR; PG8_MMA(0, 0, At, B0); PG8_MMA(0, 1, At, B1); PG8_BAR; PG8_SCHED;
            PG8_LDA(At, 0, 1); PG8_STAGE(PG8_SB(0, 0), b2, voffB); PG8_STAGE(PG8_SB(0, 1), b2 + hstep, voffB); PG8_STAGE(PG8_SA(0, 0), a2, voffA);
            PG8_WAIT_V(8); PG8_WAIT_L(0); PG8_BAR; PG8_MMA(1, 0, At, B0); PG8_MMA(1, 1, At, B1); PG8_BAR; PG8_SCHED;
            PG8_LDB(B0, 1, 0); PG8_LDB(B1, 1, 1); PG8_SCHED; PG8_LDA(At, 1, 0); PG8_STAGE(PG8_SA(0, 1), a2 + hstep, voffA);
            PG8_WAIT_V(8); PG8_WAIT_L(0); PG8_BAR; PG8_MMA(0, 0, At, B0); PG8_MMA(0, 1, At, B1); PG8_BAR; PG8_SCHED;
            PG8_LDA(At, 1, 1); PG8_STAGE(PG8_SB(1, 0), b3, voffB); PG8_STAGE(PG8_SB(1, 1), b3 + hstep, voffB); PG8_STAGE(PG8_SA(1, 0), a3, voffA);
            PG8_WAIT_V(8); PG8_WAIT_L(0); PG8_BAR; PG8_MMA(1, 0, At, B0); PG8_MMA(1, 1, At, B1); PG8_BAR; PG8_SCHED;
            } else {
            PG8_LDB(B0, 0, 0); PG8_SCHED; PG8_LDA(At, 0, 0); PG8_STAGE(PG8_SA(1, 1), a1 + hstep, voffA);
            PG8_WAIT_L(8); PG8_BAR; PG8_WAIT_L(0); PG8_MMA(0, 0, At, B0); PG8_BAR; PG8_SCHED;
            PG8_LDB(B1, 0, 1); PG8_STAGE(PG8_SB(0, 0), b2, voffB);
            PG8_BAR; PG8_WAIT_L(0); PG8_MMA(0, 1, At, B1); PG8_BAR;
            PG8_LDA(At, 0, 1); PG8_STAGE(PG8_SA(0, 0), a2, voffA);
            PG8_BAR; PG8_WAIT_L(0); PG8_MMA(1, 0, At, B0); PG8_BAR; PG8_SCHED;
            PG8_STAGE(PG8_SB(0, 1), b2 + hstep, voffB);
            PG8_WAIT_V(6); PG8_BAR; PG8_MMA(1, 1, At, B1); PG8_BAR;
            PG8_LDB(B0, 1, 0); PG8_SCHED; PG8_LDA(At, 1, 0); PG8_STAGE(PG8_SA(0, 1), a2 + hstep, voffA);
            PG8_WAIT_L(8); PG8_BAR; PG8_WAIT_L(0); PG8_MMA(0, 0, At, B0); PG8_BAR; PG8_SCHED;
            PG8_LDB(B1, 1, 1); PG8_STAGE(PG8_SB(1, 0), b3, voffB);
            PG8_BAR; PG8_WAIT_L(0); PG8_MMA(0, 1, At, B1); PG8_BAR;
            PG8_LDA(At, 1, 1); PG8_STAGE(PG8_SA(1, 0), a3, voffA);
            PG8_BAR; PG8_WAIT_L(0); PG8_MMA(1, 0, At, B0); PG8_BAR; PG8_SCHED;
            PG8_STAGE(PG8_SB(1, 1), b3 + hstep, voffB);
            PG8_WAIT_V(6); PG8_BAR; PG8_MMA(1, 1, At, B1); PG8_BAR;
            }
        }
        if constexpr (ALIGN_EPI) { if (wr == 0) PG8_BAR; }
        if constexpr (!Epi::AFTER_DRAIN) { E(acc, cur, wr, wc, fr, fq); S.done(cur); }
        if (!has_next) break;
#pragma unroll
        for (int a = 0; a < 2; ++a)
#pragma unroll
            for (int b = 0; b < 2; ++b)
#pragma unroll
                for (int m = 0; m < 4; ++m)
#pragma unroll
                    for (int n = 0; n < 2; ++n) acc[a][b][m][n] = (f32x4){0.f, 0.f, 0.f, 0.f};
        cur = nxt; cA = nA; cB = nB; ++ui;
        if constexpr (ALIGN_EPI) { if (wr == 1) PG8_BAR; }
    }
    PG8_WAIT_V(0);
    if constexpr (!ALIGN_EPI) { if (wr == 0) PG8_BAR; }
    PG8_BAR;
    if constexpr (Epi::AFTER_DRAIN) { E.fused(acc, cur, wr, wc, fr, fq, lds, wid, lane); S.done(cur); }
#undef PG8_SA
#undef PG8_SB
#undef PG8_STAGE
#undef PG8_LDA
#undef PG8_LDB
#undef PG8_MMA
#undef PG8_WAIT_V
#undef PG8_WAIT_L
#undef PG8_BAR
#undef PG8_SCHED
}
}

namespace sba {
typedef short bf16x8 __attribute__((ext_vector_type(8)));
typedef short s16x4 __attribute__((ext_vector_type(4)));
typedef float f32x16 __attribute__((ext_vector_type(16)));
typedef unsigned u32x4 __attribute__((ext_vector_type(4)));
typedef unsigned short bf16_t;
constexpr int PITCH = 1024, DH = 128, KVBLK = 64, QB = 256, SEQ_ = 4096;
constexpr int SHM_V = KVBLK * DH * 2, SHM_K = KVBLK * DH * 2;
constexpr int LDS_NEED = 2 * SHM_V + 2 * SHM_K + 64;
#define SBA_KSWZ(row, colB) ((row) * 256 + ((colB) ^ (((row) & 7) << 4)))
#define SBA_SBAR() __builtin_amdgcn_sched_barrier(0)
__device__ __forceinline__ int v_st(int k, int c) { const int kk = (k & ~0xC) | ((k & 4) << 1) | ((k & 8) >> 1); return ((kk >> 3) * 4 + (c >> 5)) * 512 + ((kk & 7) * 32 + (c & 31)) * 2; }
__device__ __forceinline__ int v_rd_base(int lane) { return ((lane & 3) << 3) | (((lane >> 2) & 3) << 6) | (((lane >> 4) & 1) << 5) | (((lane >> 5) & 1) << 8); }
constexpr int v_rd_off(int d0, int ks, int half) { return d0 * 512 + ks * 4096 + half * 2048; }
__device__ __forceinline__ int crow(int r, int hi) { return (r & 3) + 8 * (r >> 2) + 4 * hi; }
__device__ __forceinline__ unsigned cvtpk(float lo, float hi) { unsigned r; asm volatile("v_cvt_pk_bf16_f32 %0, %1, %2" : "=v"(r) : "v"(lo), "v"(hi)); return r; }

template <int KB>
__device__ __forceinline__ void qkt(f32x16& p0, f32x16& p1, const char* K_lds, int r32, int hi, const bf16x8* qr) {
    p0 = f32x16{}; p1 = f32x16{};
    const char* kb[4];
#pragma unroll
    for (int dd = 0; dd < 4; ++dd) kb[dd] = K_lds + KB * SHM_K + SBA_KSWZ(r32, (dd * 16 + hi * 8) * 2);
#pragma unroll
    for (int d0 = 0; d0 < 8; ++d0) { const char* a = kb[d0 & 3] + (d0 >> 2) * 128;
        bf16x8 b0 = *reinterpret_cast<const bf16x8*>(a);
        bf16x8 b1 = *reinterpret_cast<const bf16x8*>(a + 32 * 256);
        p0 = __builtin_amdgcn_mfma_f32_32x32x16_bf16(b0, qr[d0], p0, 0, 0, 0);
        p1 = __builtin_amdgcn_mfma_f32_32x32x16_bf16(b1, qr[d0], p1, 0, 0, 0);
        if (d0 & 1) SBA_SBAR(); }
}
template <int VB>
__device__ __forceinline__ void pv_tile(f32x16* o, int vb0, bf16x8 pa0, bf16x8 pa1, bf16x8 pa2, bf16x8 pa3) {
#define SBA_TRRD(dst, off) asm volatile("ds_read_b64_tr_b16 %0, %1 offset:%2" : "=&v"(dst) : "v"(vb0), "i"(off) : "memory")
#define SBA_PV_D0(d0) do { s16x4 l0, l1, l2, l3, h0, h1, h2, h3; constexpr int b_ = VB * SHM_V + v_rd_off(d0, 0, 0); \
        SBA_TRRD(l0, b_); SBA_TRRD(h0, b_ + 2048); SBA_TRRD(l1, b_ + 4096); SBA_TRRD(h1, b_ + 6144); SBA_TRRD(l2, b_ + 8192); SBA_TRRD(h2, b_ + 10240); SBA_TRRD(l3, b_ + 12288); SBA_TRRD(h3, b_ + 14336); \
        asm volatile("s_waitcnt lgkmcnt(0)" ::: "memory"); SBA_SBAR(); \
        o[d0] = __builtin_amdgcn_mfma_f32_32x32x16_bf16(pa0, (bf16x8){l0[0], l0[1], l0[2], l0[3], h0[0], h0[1], h0[2], h0[3]}, o[d0], 0, 0, 0); \
        o[d0] = __builtin_amdgcn_mfma_f32_32x32x16_bf16(pa1, (bf16x8){l1[0], l1[1], l1[2], l1[3], h1[0], h1[1], h1[2], h1[3]}, o[d0], 0, 0, 0); \
        o[d0] = __builtin_amdgcn_mfma_f32_32x32x16_bf16(pa2, (bf16x8){l2[0], l2[1], l2[2], l2[3], h2[0], h2[1], h2[2], h2[3]}, o[d0], 0, 0, 0); \
        o[d0] = __builtin_amdgcn_mfma_f32_32x32x16_bf16(pa3, (bf16x8){l3[0], l3[1], l3[2], l3[3], h3[0], h3[1], h3[2], h3[3]}, o[d0], 0, 0, 0); } while (0)
    SBA_PV_D0(0); SBA_PV_D0(1); SBA_PV_D0(2); SBA_PV_D0(3);
#undef SBA_PV_D0
#undef SBA_TRRD
}
template <bool MASK>
__device__ __forceinline__ void sb_tile(f32x16& p0, f32x16& p1, int dq  , int hi, float& R, bf16x8& pa0, bf16x8& pa1, bf16x8& pa2, bf16x8& pa3) {
    float T[8];
#pragma unroll
    for (int g = 0; g < 8; ++g) {
        float lb[4], x[4];
#pragma unroll
        for (int i = 0; i < 4; ++i) {
            const int r = (g & 3) * 4 + i; const float z = (g < 4) ? p0[r] : p1[r];
            const float e = __builtin_amdgcn_exp2f(-__builtin_fabsf(z));
            const float l = __builtin_amdgcn_logf(1.0f + e);
            lb[i] = __builtin_fminf(z, 0.f) - l; x[i] = lb[i] - z;
            if (MASK) { const int c = i + 8 * (g & 3) + 32 * (g >> 2); const bool valid = (dq - c) > 0; x[i] = valid ? x[i] : 0.f; lb[i] = valid ? lb[i] : -__builtin_inff(); }
        }
        const float s2 = x[3], s1 = x[3] + x[2], s0 = s1 + x[1];
        T[g] = s0 + x[0];
        lb[0] += s0; lb[1] += s1; lb[2] += s2;
#pragma unroll
        for (int i = 0; i < 4; ++i) { const int r = (g & 3) * 4 + i; if (g < 4) p0[r] = lb[i]; else p1[r] = lb[i]; }
        if (g & 1) SBA_SBAR();
    }
    float run = 0.f, tot = 0.f;
#pragma unroll
    for (int g = 7; g >= 0; --g) {
        const float se = run, si = run + T[g]; run = si;
        auto rr = __builtin_amdgcn_permlane32_swap(__float_as_uint(si), __float_as_uint(se), false, false);
        const float part = hi ? __uint_as_float(rr[0]) : __uint_as_float(rr[1]);
        const float base = se + part + R;
        if (g == 0) { auto r2 = __builtin_amdgcn_permlane32_swap(__float_as_uint(si), __float_as_uint(si), false, false); tot = __uint_as_float(r2[0]) + __uint_as_float(r2[1]); }
#pragma unroll
        for (int i = 0; i < 4; ++i) { const int r = (g & 3) * 4 + i; if (g < 4) p0[r] = __builtin_amdgcn_exp2f(p0[r] + base); else p1[r] = __builtin_amdgcn_exp2f(p1[r] + base); }
        if (!(g & 1)) SBA_SBAR();
    }
    R += tot;
#define SBA_PK4(P, B_, OUT) do { unsigned a0 = cvtpk(P[B_+0], P[B_+1]), a1 = cvtpk(P[B_+2], P[B_+3]); \
        unsigned b0 = cvtpk(P[B_+4], P[B_+5]), b1 = cvtpk(P[B_+6], P[B_+7]); \
        auto r0 = __builtin_amdgcn_permlane32_swap(a0, b0, false, false); auto r1 = __builtin_amdgcn_permlane32_swap(a1, b1, false, false); \
        u32x4 w = {r0[0], r1[0], r0[1], r1[1]}; OUT = *reinterpret_cast<bf16x8*>(&w); } while (0)
    SBA_PK4(p0, 0, pa0); SBA_PK4(p0, 8, pa1); SBA_PK4(p1, 0, pa2); SBA_PK4(p1, 8, pa3);
#undef SBA_PK4
}
template <bool EARLY>
__device__ __forceinline__ void attn_unit(int b, int h, int qb, const bf16_t* Q, const bf16_t* K, const bf16_t* V, bf16_t* O, char* lds) {
    constexpr float RTHR = 160.f;
    typedef __attribute__((address_space(3))) unsigned lds_u32;
    const int tid = threadIdx.x, wid = __builtin_amdgcn_readfirstlane(tid >> 6), lane = tid & 63, r32 = lane & 31, hi = lane >> 5;
    const long rowbase = (long)b * SEQ_; const int q0 = qb * QB;
    const int qlo = q0 + wid * 32, qpos = qlo + r32;
    char* V_lds = lds; char* K_lds = lds + 2 * SHM_V; volatile unsigned* vote = (volatile unsigned*)(lds + 2 * SHM_V + 2 * SHM_K);
    const bf16_t* Qw = Q + (rowbase + qpos) * PITCH + h * DH;
    bf16x8 qr[8];
#pragma unroll
    for (int d0 = 0; d0 < 8; ++d0) qr[d0] = *reinterpret_cast<const bf16x8*>(Qw + d0 * 16 + hi * 8);
    const bf16_t* Kh = K + rowbase * PITCH + h * DH; const bf16_t* Vh = V + rowbase * PITCH + h * DH;
    int kof[2], vof[2];
#pragma unroll
    for (int i = 0; i < 2; ++i) {
        const int row = 8 * wid + 4 * i + (lane >> 4), pos = lane & 15; kof[i] = row * PITCH + ((pos ^ (row & 7)) << 3);
        const int st = 2 * (2 * wid + i) + (lane >> 5), kk = (st >> 2) * 8 + ((lane & 31) >> 2), c = (st & 3) * 32 + (lane & 3) * 8, k = (kk & ~0xC) | ((kk & 4) << 1) | ((kk & 8) >> 1);
        vof[i] = k * PITCH + c; }
    const int vb0 = (int)(uintptr_t)V_lds + v_rd_base(lane);
    lds_u32* const ldsK = (lds_u32*)(uintptr_t)(unsigned)(uintptr_t)(K_lds + wid * 2048);
    lds_u32* const ldsV = (lds_u32*)(uintptr_t)(unsigned)(uintptr_t)(V_lds + wid * 2048);
#define SBA_ISSUE(bf, k0) do { const bf16_t* kp_ = Kh + (size_t)(k0) * PITCH; const bf16_t* vp_ = Vh + (size_t)(k0) * PITCH; \
        __builtin_amdgcn_global_load_lds((const unsigned*)(kp_ + kof[0]), ldsK + ((bf) * SHM_K) / 4, 16, 0, 0); __builtin_amdgcn_global_load_lds((const unsigned*)(kp_ + kof[1]), ldsK + ((bf) * SHM_K + 1024) / 4, 16, 0, 0); \
        __builtin_amdgcn_global_load_lds((const unsigned*)(vp_ + vof[0]), ldsV + ((bf) * SHM_V) / 4, 16, 0, 0); __builtin_amdgcn_global_load_lds((const unsigned*)(vp_ + vof[1]), ldsV + ((bf) * SHM_V + 1024) / 4, 16, 0, 0); } while (0)
    const int NT = (q0 + QB) / KVBLK;
    f32x16 o[4] = {}; float R = 0.f;
    SBA_ISSUE(0, (NT - 1) * KVBLK);
    if (EARLY && tid < 16) vote[tid] = 0u;
    asm volatile("s_waitcnt vmcnt(0)" ::: "memory"); __syncthreads();
#define SBA_STEP(BUF, t) do { const int kb_ = (t) * KVBLK; \
        if ((t) > 0) SBA_ISSUE((BUF) ^ 1, kb_ - KVBLK); \
        if (kb_ <= qlo + 30) {                                     \
            f32x16 p0, p1; bf16x8 pa0, pa1, pa2, pa3; \
            qkt<BUF>(p0, p1, K_lds, r32, hi, qr); \
            sb_tile<true>(p0, p1, (kb_ + KVBLK - 1 >= qlo) ? qpos - kb_ - 4 * hi : (1 << 20), hi, R, pa0, pa1, pa2, pa3);     \
            SBA_SBAR(); pv_tile<BUF>(o, vb0, pa0, pa1, pa2, pa3); } \
        if (EARLY) { const bool done_ = __all(R < -RTHR); if (lane == 0) vote[((t) & 1) * 8 + wid] = done_ ? 1u : 0u; } \
        asm volatile("s_waitcnt vmcnt(0)" ::: "memory"); __syncthreads(); \
    } while (0)
    for (int it = 0; it < NT; it += 2) {
        const int t = NT - 1 - it;
        SBA_STEP(0, t);
        if (EARLY) { unsigned a = 1u; for (int w = 0; w < 8; ++w) a &= vote[(t & 1) * 8 + w]; if (a) break; }
        SBA_STEP(1, t - 1);
        if (EARLY) { unsigned a = 1u; for (int w = 0; w < 8; ++w) a &= vote[((t - 1) & 1) * 8 + w]; if (a) break; }
    }
    bf16_t* Ow = O + (rowbase + qlo) * PITCH + h * DH;
#pragma unroll
    for (int r = 0; r < 16; ++r) { const int orow = crow(r, hi);
#pragma unroll
        for (int d0 = 0; d0 < 4; ++d0) { const float v = o[d0][r]; const float vn = __shfl_xor(v, 1);
            if ((r32 & 1) == 0) *(unsigned*)(Ow + (size_t)orow * PITCH + d0 * 32 + r32) = cvtpk(v, vn); } }
    asm volatile("s_waitcnt vmcnt(0)" ::: "memory"); __syncthreads();
#undef SBA_STEP
#undef SBA_ISSUE
}
#undef SBA_KSWZ
#undef SBA_SBAR
}

#define GAS __attribute__((address_space(1)))
#define LAS __attribute__((address_space(3)))
typedef unsigned short bf16;
typedef unsigned v4u __attribute__((ext_vector_type(4)));
typedef float f32x4 __attribute__((ext_vector_type(4)));
typedef short bf16x8 __attribute__((ext_vector_type(8)));
typedef GAS unsigned gu32;
typedef GAS unsigned long long gu64;
#define RLX_AGENT __ATOMIC_RELAXED, __HIP_MEMORY_SCOPE_AGENT
#define LDS_WAIT() asm volatile("s_waitcnt lgkmcnt(0)" ::: "memory")
#define VM_WAIT() asm volatile("s_waitcnt vmcnt(0)" ::: "memory")
__device__ __forceinline__ unsigned long long rt() { return __builtin_amdgcn_s_memrealtime(); }
__device__ __forceinline__ unsigned f2bf(float f) { unsigned u = __builtin_bit_cast(unsigned, f); return (u + 0x7fffu + ((u >> 16) & 1u)) >> 16; }
__device__ __forceinline__ unsigned pk2(float lo, float hi) { return f2bf(lo) | (f2bf(hi) << 16); }

#define XB_TMO      128
#define XB_XCNT(j)  (256  + 64 * (j))
#define XB_XSUB(j)  (1280 + 64 * (j))
#define XB_XGEN(j)  (2304 + 64 * (j))
#define XB_TOP      3328
#define XB_TOPGEN   3392
#define XCD_BAR_WORDS 3456
#define XB_SPIN_CAP (1u << 18)

__device__ __forceinline__ unsigned xb_ld(unsigned* p)              { return __hip_atomic_load(p, __ATOMIC_RELAXED, __HIP_MEMORY_SCOPE_AGENT); }
__device__ __forceinline__ unsigned xb_add(unsigned* p, unsigned v) { return __hip_atomic_fetch_add(p, v, __ATOMIC_RELAXED, __HIP_MEMORY_SCOPE_AGENT); }
__device__ __forceinline__ unsigned xb_xcc_id() { return (unsigned)__builtin_amdgcn_s_getreg((3 << 11) | 20) & 0xFu; }
#define XB_SPIN(cond, bar) do { unsigned _sp = 0; while (cond) { __builtin_amdgcn_s_sleep(1); \
    if ((++_sp & 255u) == 0u) { if (xb_ld(&(bar)[XB_TMO])) break; if (_sp > XB_SPIN_CAP) { atomicAdd(&(bar)[XB_TMO], 1u); break; } } } } while (0)

struct XcdBarrier {
    unsigned* bar; unsigned x;
    volatile LAS unsigned* st;
};

__device__ __forceinline__ XcdBarrier xcd_barrier_post(unsigned* bar, volatile LAS unsigned* st) {
    XcdBarrier b; b.bar = bar; b.x = xb_xcc_id(); b.st = st;
    if (threadIdx.x == 0) (void)xb_add(&bar[XB_XCNT(b.x)], 1u);
    return b;
}
__device__ __forceinline__ void xcd_barrier_complete(unsigned* bar, unsigned x, unsigned& nloc, unsigned& nx) {
    const unsigned G = gridDim.x * gridDim.y * gridDim.z;
    unsigned sum, cnt, mine, sp = 0u;
    for (;;) {
        sum = 0u; cnt = 0u; mine = 0u;
#pragma unroll
        for (unsigned j = 0; j < 16; ++j) { const unsigned c = xb_ld(&bar[XB_XCNT(j)]); sum += c; cnt += (c > 0u) ? 1u : 0u; mine = (j == x) ? c : mine; }
        if (sum == G) break;
        __builtin_amdgcn_s_sleep(1);
        if ((++sp & 255u) == 0u) { if (xb_ld(&bar[XB_TMO])) break; if (sp > XB_SPIN_CAP) { atomicAdd(&bar[XB_TMO], 1u); break; } }
    }
    nloc = mine > 0u ? mine : 1u; nx = cnt > 0u ? cnt : 1u;
}

__device__ __forceinline__ void xcd_barrier(const XcdBarrier& b) {
    asm volatile("s_waitcnt vmcnt(0)" ::: "memory");
    __syncthreads();
    if (threadIdx.x == 0) {
        unsigned* bar = b.bar;
        __builtin_amdgcn_s_waitcnt(0);
        unsigned nloc = b.st[0], nx = b.st[1];
        if (nloc == 0u) { xcd_barrier_complete(bar, b.x, nloc, nx); b.st[0] = nloc; b.st[1] = nx; }
        const unsigned old = xb_add(&bar[XB_XSUB(b.x)], 1u);
        const unsigned gen = old / nloc;
        if (old + 1u == (gen + 1u) * nloc) {
            __builtin_amdgcn_fence(__ATOMIC_RELEASE, "agent");
            asm volatile("s_waitcnt vmcnt(0)" ::: "memory");
            const unsigned og = xb_add(&bar[XB_TOP], 1u);
            const unsigned tg = og / nx;
            if (og + 1u == (tg + 1u) * nx) xb_add(&bar[XB_TOPGEN], 1u);
            else XB_SPIN(xb_ld(&bar[XB_TOPGEN]) == tg, bar);
            __builtin_amdgcn_fence(__ATOMIC_ACQUIRE, "agent");
            xb_add(&bar[XB_XGEN(b.x)], 1u);
            asm volatile("s_waitcnt vmcnt(0)" ::: "memory");
        } else {
            XB_SPIN(xb_ld(&bar[XB_XGEN(b.x)]) == gen, bar);
            __builtin_amdgcn_fence(__ATOMIC_ACQUIRE, "agent");
            asm volatile("s_waitcnt vmcnt(0)" ::: "memory");
        }
    }
    __syncthreads();
}

constexpr int NWAVES = 8;
constexpr int BATCH = 4, SEQ = 4096, D = 1024, M = BATCH * SEQ, FF = 3072, NH = 8, HD = 128;
constexpr float DN_ALPHA = 1.4142135623730951f;
constexpr float LN_EPS = 1e-5f;
constexpr float QSCALE = 0.08838834764831845f * 1.4426950408889634f;
constexpr size_t MiB = 1u << 20;
constexpr size_t WS_CTL = 0, CTL_ZERO_BYTES = 1 * MiB;
constexpr size_t WS_WIN = 1 * MiB, WS_WOUT = 5 * MiB, WS_WQKV = 7 * MiB, WS_WAO = 13 * MiB, WS_WUP = 15 * MiB, WS_WDN = 39 * MiB, WS_WG = 51 * MiB;
constexpr size_t WS_CSUM = 52 * MiB;
constexpr size_t WS_TSUM = 53 * MiB;
constexpr size_t WS_HPREV = 57 * MiB, WS_HCUR = 60 * MiB;
constexpr size_t WS_XB = 63 * MiB;
constexpr size_t WS_XF = 95 * MiB;
constexpr size_t WS_BIG = 159 * MiB;
constexpr size_t WS_END = 255 * MiB;
constexpr int CW_BAR = 4096;

constexpr int RING_OFF = 0, RING_BYTES = 131072;
constexpr int EXTRA_OFF = RING_BYTES, EXTRA_BYTES = 16384;
constexpr int LDSCTL_OFF = EXTRA_OFF + EXTRA_BYTES, MISC_OFF = LDSCTL_OFF + 320;
constexpr int LDS_BYTES = 151552;
static_assert(MISC_OFF + 128 <= LDS_BYTES, "LDS map");

typedef float f32x16 __attribute__((ext_vector_type(16)));
__device__ __forceinline__ float bf2f(unsigned short b) { return __builtin_bit_cast(float, (unsigned)b << 16); }
__device__ __forceinline__ float wave_sum(float v) {
#pragma unroll
    for (int o = 1; o < 64; o <<= 1) v += __shfl_xor(v, o);
    return v;
}

template <int MAP>
__device__ __forceinline__ void p0_transpose_item(const float* W, int K, int N, bf16* WT, int row_off, LAS float* scr, int item, int lane) {
    const int nblk = N / 32, kb = item / nblk, nb = item % nblk, k0 = 64 * kb, n0 = 32 * nb;
#pragma unroll 8
    for (int i = 0; i < 32; ++i) { const int kk = 2 * i + (lane >> 5); scr[kk * 33 + (lane & 31)] = W[(size_t)(k0 + kk) * N + n0 + (lane & 31)]; }
    LDS_WAIT(); asm volatile("" ::: "memory");
    int r0;
    if (MAP == 0) r0 = row_off + n0; else r0 = (n0 < 3072) ? (256 * (n0 / 128) + (n0 % 128)) : (256 * ((n0 - 3072) / 128) + 128 + ((n0 - 3072) % 128));
    const int c = lane & 7;
#pragma unroll
    for (int j = 0; j < 4; ++j) { const int n = (lane >> 3) + 8 * j; const LAS float* s = scr + (8 * c) * 33 + n;
        v4u o; o.x = pk2(s[0 * 33], s[1 * 33]); o.y = pk2(s[2 * 33], s[3 * 33]); o.z = pk2(s[4 * 33], s[5 * 33]); o.w = pk2(s[6 * 33], s[7 * 33]);
        *(GAS v4u*)(WT + (size_t)(r0 + n) * K + k0 + 8 * c) = o; }
    LDS_WAIT(); asm volatile("" ::: "memory");
}
struct Ptrs {
    const float* in[19]; float* out; unsigned char* ws;
};
__device__ __forceinline__ void p0_prologue(const Ptrs& P, LAS unsigned char* lds, int vcu, int G, int wave, int lane) {
    LAS float* scr = (LAS float*)(lds + RING_OFF + wave * 16384);
    const int gw = vcu * NWAVES + wave, NGW = G * NWAVES;
    unsigned char* ws = P.ws;
    constexpr int I_WIN = 16 * 64, I_SQ = 16 * 32, I_KV = 16 * 64, I_UP = 16 * 192, I_DN = 48 * 32, I_G = 2 * 8;
    constexpr int NITEMS = I_WIN + I_SQ + I_SQ + I_KV + I_SQ + 2 * I_UP + 2 * I_DN + 8 * I_G;
    for (int it = gw; it < NITEMS; it += NGW) {
        int r = it;
        if (r < I_WIN) { p0_transpose_item<0>(P.in[1], 1024, 2048, (bf16*)(ws + WS_WIN), 0, scr, r, lane); continue; } r -= I_WIN;
        if (r < I_SQ) { p0_transpose_item<0>(P.in[8], 1024, 1024, (bf16*)(ws + WS_WOUT), 0, scr, r, lane); continue; } r -= I_SQ;
        if (r < I_SQ) { p0_transpose_item<0>(P.in[11], 1024, 1024, (bf16*)(ws + WS_WQKV), 0, scr, r, lane); continue; } r -= I_SQ;
        if (r < I_KV) { p0_transpose_item<0>(P.in[10], 1024, 2048, (bf16*)(ws + WS_WQKV), 1024, scr, r, lane); continue; } r -= I_KV;
        if (r < I_SQ) { p0_transpose_item<0>(P.in[12], 1024, 1024, (bf16*)(ws + WS_WAO), 0, scr, r, lane); continue; } r -= I_SQ;
        if (r < 2 * I_UP) { const int l = r / I_UP; p0_transpose_item<1>(P.in[13] + (size_t)l * 1024 * 6144, 1024, 6144, (bf16*)(ws + WS_WUP) + (size_t)l * 6144 * 1024, 0, scr, r % I_UP, lane); continue; } r -= 2 * I_UP;
        if (r < 2 * I_DN) { const int l = r / I_DN; p0_transpose_item<0>(P.in[16] + (size_t)l * 3072 * 1024, 3072, 1024, (bf16*)(ws + WS_WDN) + (size_t)l * 1024 * 3072, 0, scr, r % I_DN, lane); continue; } r -= 2 * I_DN;
        { const int n = r / I_G; p0_transpose_item<0>(P.in[5] + (size_t)n * 128 * 256, 128, 256, (bf16*)(ws + WS_WG) + (size_t)n * 256 * 128, 0, scr, r % I_G, lane); }
    }
    const float* x = P.in[0]; bf16* XB = (bf16*)(ws + WS_XB);
    for (int m = gw; m < M; m += NGW) {
        const GAS f32x4* xr = (const GAS f32x4*)(x + (size_t)m * D) + lane;
        GAS unsigned long long* o8 = (GAS unsigned long long*)(XB + (size_t)m * D) + lane;
#pragma unroll
        for (int j = 0; j < 4; ++j) { const f32x4 v = xr[64 * j]; o8[64 * j] = (unsigned long long)pk2(v.x, v.y) | ((unsigned long long)pk2(v.z, v.w) << 32); }
    }
}
__device__ __forceinline__ void ln_pass(float* X, bf16* XB, const float* g, const float* bta, int vcu, int G, int wave, int lane) {
    const int gw = vcu * NWAVES + wave, NGW = G * NWAVES;
    f32x4 gv[4], bv[4];
#pragma unroll
    for (int j = 0; j < 4; ++j) { gv[j] = *((const f32x4*)g + lane + 64 * j); bv[j] = *((const f32x4*)bta + lane + 64 * j); }
    for (int m = gw; m < M; m += NGW) {
        GAS f32x4* xr = (GAS f32x4*)(X + (size_t)m * D) + lane;
        f32x4 v[4]; float s = 0.f;
#pragma unroll
        for (int j = 0; j < 4; ++j) { v[j] = xr[64 * j]; s += (v[j].x + v[j].y) + (v[j].z + v[j].w); }
        const float mean = wave_sum(s) * (1.f / D); float s2 = 0.f;
#pragma unroll
        for (int j = 0; j < 4; ++j) { v[j] = v[j] - mean; s2 += (v[j].x * v[j].x + v[j].y * v[j].y) + (v[j].z * v[j].z + v[j].w * v[j].w); }
        const float rstd = 1.f / sqrtf(wave_sum(s2) * (1.f / D) + LN_EPS);
        GAS unsigned long long* o8 = (GAS unsigned long long*)(XB + (size_t)m * D) + lane;
#pragma unroll
        for (int j = 0; j < 4; ++j) { const f32x4 y = v[j] * rstd * gv[j] + bv[j]; xr[64 * j] = y; o8[64 * j] = (unsigned long long)pk2(y.x, y.y) | ((unsigned long long)pk2(y.z, y.w) << 32); }
    }
}

#define RG_SWZ(row, chunk) ((row) * 256 + ((((chunk) ^ (row)) & 15) << 4))
template <int PASS>
__device__ __forceinline__ void rg_pass(const Ptrs& P, LAS unsigned char* lds, int vcu, int G) {
    const int tid = threadIdx.x, wid = __builtin_amdgcn_readfirstlane(tid >> 6), lane = tid & 63, r32 = lane & 31, hi = lane >> 5;
    unsigned char* ws = P.ws;
    const bf16* XR = (const bf16*)(ws + WS_BIG + 32 * MiB); const bf16* Y = (const bf16*)(ws + WS_BIG); bf16* HY = (bf16*)(ws + WS_BIG + 64 * MiB);
    const bf16* WG = (const bf16*)(ws + WS_WG);
    float* CSUM = (float*)(ws + WS_CSUM); float* TSUM = (float*)(ws + WS_TSUM);
    const float* conv_w = P.in[3]; const float* conv_b = P.in[4]; const float* b_gates = P.in[6]; const float* a_param = P.in[7];
    LAS unsigned char* XBR = lds + RING_OFF;
    LAS unsigned char* WGL = lds + RING_OFF + 65536;
    LAS float* WSUM = (LAS float*)(lds + EXTRA_OFF);
    int cur_n = -1;
    for (int unit = vcu; unit < 512; unit += G) {
        const int n = unit & 7, j = (unit >> 3) & 15, b = unit >> 7;
        const size_t tok0 = (size_t)b * SEQ + (size_t)j * 256;
        __syncthreads();
        if (n != cur_n) { cur_n = n;
#pragma unroll
            for (int it = 0; it < 8; ++it) { const int idx = it * 512 + tid, col = idx >> 4, ch = idx & 15;
                *(LAS v4u*)(WGL + RG_SWZ(col, ch)) = *(const GAS v4u*)(WG + ((size_t)n * 256 + col) * 128 + ch * 8); } }
        { const int cg = tid & 15, rg = tid >> 4, c0 = n * 128 + cg * 8;
            float w[4][8], cbv[8];
#pragma unroll
            for (int k = 0; k < 4; ++k) { const f32x4 a = *(const f32x4*)(conv_w + k * 1024 + c0), bq = *(const f32x4*)(conv_w + k * 1024 + c0 + 4);
                w[k][0] = a.x; w[k][1] = a.y; w[k][2] = a.z; w[k][3] = a.w; w[k][4] = bq.x; w[k][5] = bq.y; w[k][6] = bq.z; w[k][7] = bq.w; }
            { const f32x4 a = *(const f32x4*)(conv_b + c0), bq = *(const f32x4*)(conv_b + c0 + 4); cbv[0] = a.x; cbv[1] = a.y; cbv[2] = a.z; cbv[3] = a.w; cbv[4] = bq.x; cbv[5] = bq.y; cbv[6] = bq.z; cbv[7] = bq.w; }
            bf16x8 xin[11];
#pragma unroll
            for (int i = 0; i < 11; ++i) { const int row = rg * 8 - 3 + i;
                if (row >= 0 || j > 0) xin[i] = *(const GAS bf16x8*)(XR + (tok0 + row) * 1024 + c0); else xin[i] = (bf16x8){0, 0, 0, 0, 0, 0, 0, 0}; }
#pragma unroll
            for (int i = 0; i < 8; ++i) { float y[8];
#pragma unroll
                for (int c = 0; c < 8; ++c) y[c] = cbv[c] + w[0][c] * bf2f((unsigned short)xin[i][c]) + w[1][c] * bf2f((unsigned short)xin[i + 1][c]) + w[2][c] * bf2f((unsigned short)xin[i + 2][c]) + w[3][c] * bf2f((unsigned short)xin[i + 3][c]);
                v4u o; o.x = pk2(y[0], y[1]); o.y = pk2(y[2], y[3]); o.z = pk2(y[4], y[5]); o.w = pk2(y[6], y[7]);
                const int row = rg * 8 + i; *(LAS v4u*)(XBR + RG_SWZ(row, cg)) = o; }
        }
        if (PASS == 2) {
            if (tid < 128) { const int cgl = n * 128 + tid; float C = 0.f;
                for (int jj = 0; jj < j; ++jj) { const float2 s = *(const float2*)(CSUM + (((size_t)b * 16 + jj) * 1024 + cgl) * 2); C = s.x * C + s.y; }
#pragma unroll
                for (int w = 0; w < 8; ++w) { WSUM[w * 128 + tid] = C; const float2 s = *(const float2*)(TSUM + (((size_t)b * 128 + j * 8 + w) * 1024 + cgl) * 2); C = s.x * C + s.y; } }
        }
        __syncthreads();
        bf16x8 af[8];
        { const int row = wid * 32 + r32;
#pragma unroll
            for (int kk = 0; kk < 8; ++kk) af[kk] = *(const LAS bf16x8*)(XBR + RG_SWZ(row, 2 * kk + hi)); }
#pragma unroll 1
        for (int q = 0; q < 4; ++q) {
            const int cl = q * 32 + r32, cgl = n * 128 + cl;
            f32x16 ai = {}, ar = {};
#pragma unroll
            for (int kk = 0; kk < 8; ++kk) {
                const bf16x8 bi = *(const LAS bf16x8*)(WGL + RG_SWZ(cl, 2 * kk + hi)), br = *(const LAS bf16x8*)(WGL + RG_SWZ(128 + cl, 2 * kk + hi));
                ai = __builtin_amdgcn_mfma_f32_32x32x16_bf16(af[kk], bi, ai, 0, 0, 0);
                ar = __builtin_amdgcn_mfma_f32_32x32x16_bf16(af[kk], br, ar, 0, 0, 0); }
            const float bi_ = b_gates[n * 256 + cl], br_ = b_gates[n * 256 + 128 + cl];
            const float spc = 8.0f * log1pf(expf(-a_param[cgl]));
            float yv[16];
            if (PASS == 2) {
#pragma unroll
                for (int r = 0; r < 16; ++r) yv[r] = bf2f(Y[(tok0 + wid * 32 + sba::crow(r, hi)) * 1024 + cgl]);
            }
            float hl[16], pa[16];
#pragma unroll
            for (int r = 0; r < 16; ++r) {
                const int trow = wid * 32 + sba::crow(r, hi);
                const float xb = bf2f(*(const LAS unsigned short*)(XBR + RG_SWZ(trow, cl >> 3) + (cl & 7) * 2));
                const float gi = __builtin_amdgcn_rcpf(1.0f + __expf(-(ai[r] + bi_)));
                const float gr = __builtin_amdgcn_rcpf(1.0f + __expf(-(ar[r] + br_)));
                const float a = __expf(-gr * spc);
                float mult = sqrtf(fmaxf(1.0f - a * a, 0.f));
                if (j == 0 && trow == 0) mult = 1.0f;
                pa[r] = a; hl[r] = mult * gi * xb;
            }
#pragma unroll
            for (int g = 0; g < 4; ++g)
#pragma unroll
                for (int i = 1; i < 4; ++i) { hl[4 * g + i] = pa[4 * g + i] * hl[4 * g + i - 1] + hl[4 * g + i]; pa[4 * g + i] = pa[4 * g + i] * pa[4 * g + i - 1]; }
            float PAb[4], PHb[4];
            float AW = 1.f, HW = 0.f;
#pragma unroll
            for (int g = 0; g < 4; ++g) {
                auto ra = __builtin_amdgcn_permlane32_swap(__float_as_uint(pa[4 * g + 3]), __float_as_uint(pa[4 * g + 3]), false, false);
                auto rh = __builtin_amdgcn_permlane32_swap(__float_as_uint(hl[4 * g + 3]), __float_as_uint(hl[4 * g + 3]), false, false);
                const float Alo = __uint_as_float(ra[0]), Ahi = __uint_as_float(ra[1]), Hlo = __uint_as_float(rh[0]), Hhi = __uint_as_float(rh[1]);
                if (hi == 0) { PAb[g] = AW; PHb[g] = HW; }
                HW = Alo * HW + Hlo; AW = Alo * AW;
                if (hi == 1) { PAb[g] = AW; PHb[g] = HW; }
                HW = Ahi * HW + Hhi; AW = Ahi * AW;
            }
            if (PASS == 1) {
                if (hi == 0) { *(float2*)(TSUM + (((size_t)b * 128 + j * 8 + wid) * 1024 + cgl) * 2) = make_float2(AW, HW); WSUM[(wid * 128 + cl) * 2] = AW; WSUM[(wid * 128 + cl) * 2 + 1] = HW; }
            } else {
                const float C = WSUM[wid * 128 + cl];
#pragma unroll
                for (int g = 0; g < 4; ++g) { const float E = PAb[g] * C + PHb[g];
#pragma unroll
                    for (int i = 0; i < 4; ++i) { const int r = 4 * g + i; const float h = hl[r] + pa[r] * E;
                        HY[(tok0 + wid * 32 + sba::crow(r, hi)) * 1024 + cgl] = (bf16)f2bf(h * yv[r]); } }
            }
        }
        if (PASS == 1) {
            __syncthreads();
            if (tid < 128) { float A = 1.f, H = 0.f;
#pragma unroll
                for (int w = 0; w < 8; ++w) { const float a = WSUM[(w * 128 + tid) * 2], h = WSUM[(w * 128 + tid) * 2 + 1]; H = a * H + h; A = a * A; }
                *(float2*)(CSUM + (((size_t)b * 16 + j) * 1024 + n * 128 + tid) * 2) = make_float2(A, H); }
        }
    }
}
#undef RG_SWZ

__device__ __forceinline__ void ffn_fixup(int pm, bf16* Gb, const float* hprev, const float* hcur, const float* cw, const float* cb) {
    if ((pm & 15) == 0) return;
    const float* pv = hprev + (size_t)(pm - 1) * 2 * 6144; const float* cv = hcur + (size_t)pm * 2 * 6144;
    for (int oc = threadIdx.x; oc < 3072; oc += 512) {
        const int i1 = 256 * (oc >> 7) + (oc & 127), i2 = i1 + 128, c1 = oc, c2 = 3072 + oc;
        const float p0a = pv[i1], p1a = pv[6144 + i1], c0a = cv[i1], c1a = cv[6144 + i1];
        const float p0b = pv[i2], p1b = pv[6144 + i2], c0b = cv[i2], c1b = cv[6144 + i2];
        const float w0a = cw[c1], w1a = cw[6144 + c1], w2a = cw[2 * 6144 + c1], ba = cb[c1];
        const float w0b = cw[c2], w1b = cw[6144 + c2], w2b = cw[2 * 6144 + c2], bb = cb[c2];
        const float y0a = ba + w0a * p0a + w1a * p1a + w2a * c0a, y0b = bb + w0b * p0b + w1b * p1b + w2b * c0b;
        const float y1a = ba + w0a * p1a + w1a * c0a + w2a * c1a, y1b = bb + w0b * p1b + w1b * c0b + w2b * c1b;
        Gb[(size_t)(pm * 256) * 3072 + oc] = (bf16)f2bf(pg8::gelu_tanh(y0a) * y0b);
        Gb[(size_t)(pm * 256 + 1) * 3072 + oc] = (bf16)f2bf(pg8::gelu_tanh(y1a) * y1b);
    }
}

#ifndef MK_PER_PHASE
#define MK_PER_PHASE 0
#endif
constexpr int N_PHASES = 16;
struct Args { const float* in[19]; float* out; unsigned char* ws; int ph_lo, ph_hi, li, pad; };
__global__ void __launch_bounds__(NWAVES * 64, 2) yoco_fwd(Args args) {
    extern __shared__ __attribute__((aligned(16))) unsigned char lds_raw[];
    LAS unsigned char* lds = (LAS unsigned char*)lds_raw;
    volatile LAS unsigned* MISC = (volatile LAS unsigned*)(lds + MISC_OFF);
    const int tid = threadIdx.x, lane = tid & 63, wave = __builtin_amdgcn_readfirstlane(tid >> 6);
    const int G = gridDim.x; const int bx = blockIdx.x; const int vcu = (G % 8 == 0) ? (bx % 8) * (G / 8) + bx / 8 : bx;
    unsigned char* ws = args.ws;
    gu32* ctl = (gu32*)(ws + WS_CTL);
    Ptrs P; for (int i = 0; i < 19; ++i) P.in[i] = args.in[i]; P.out = args.out; P.ws = ws;
    for (int u = tid; u < (LDS_BYTES - LDSCTL_OFF) / 4; u += NWAVES * 64) ((LAS unsigned*)(lds + LDSCTL_OFF))[u] = 0u;
    __syncthreads();
    XcdBarrier bar; bar.bar = (unsigned*)(ctl + CW_BAR); bar.x = 0; bar.st = nullptr;
    if (!MK_PER_PHASE) bar = xcd_barrier_post((unsigned*)(ctl + CW_BAR), MISC + 8);
    const int lo = args.ph_lo, hi_ = args.ph_hi;
#ifndef PHMASK
#define PHMASK 0xFFFF
#endif
#define IN(k) ((((PHMASK) >> (k)) & 1) && lo <= (k) && (k) < hi_)
#define SEAM(k) do { if (IN(k) && IN((k) + 1)) xcd_barrier(bar); } while (0)
    bf16* XB = (bf16*)(ws + WS_XB); float* XF = (float*)(ws + WS_XF);
    bf16* BIG = (bf16*)(ws + WS_BIG);
    bf16* Yb = BIG; bf16* XRb = (bf16*)(ws + WS_BIG + 32 * MiB); bf16* HYb = (bf16*)(ws + WS_BIG + 64 * MiB);
    bf16* Qb = BIG; bf16* Kb = XRb; bf16* Vb = HYb;
    float* HPREV = (float*)(ws + WS_HPREV); float* HCUR = (float*)(ws + WS_HCUR);
    const float* ln_g = P.in[17]; const float* ln_b = P.in[18];

    if (IN(0)) { p0_prologue(P, lds, vcu, G, wave, lane); } SEAM(0);
    if (IN(1)) { pg8::Gemm g{XB, (const bf16*)(ws + WS_WIN), M, 2048, D}; pg8::StaticOrder S; S.init(M, 2048, G, bx);
        pg8::EpiG1 E{Yb, XRb, P.in[2]}; pg8::gemm_phase<pg8::EpiG1, pg8::StaticOrder, true, true>(lds + RING_OFF, g, S, E); } SEAM(1);
    if (IN(2)) { rg_pass<1>(P, lds, vcu, G); } SEAM(2);
    if (IN(3)) { rg_pass<2>(P, lds, vcu, G); } SEAM(3);
    if (IN(4)) { pg8::Gemm g{HYb, (const bf16*)(ws + WS_WOUT), M, D, D}; pg8::StaticOrder S; S.init(M, D, G, bx);
        pg8::EpiSum E{P.in[0], XF, P.in[9], DN_ALPHA}; pg8::gemm_phase<pg8::EpiSum, pg8::StaticOrder, true, true>(lds + RING_OFF, g, S, E); } SEAM(4);
    if (IN(5)) { ln_pass(XF, XB, ln_g + 0 * D, ln_b + 0 * D, vcu, G, wave, lane); } SEAM(5);
    if (IN(6)) { pg8::Gemm g{XB, (const bf16*)(ws + WS_WUP), M, 2 * FF, D}; pg8::StaticOrder S; S.init(M, 2 * FF, G, bx);
        pg8::EpiFfnUp E{BIG, P.in[14], P.in[15], HPREV, HCUR, (LAS float*)(lds + EXTRA_OFF)}; pg8::gemm_phase<pg8::EpiFfnUp, pg8::StaticOrder, true, true>(lds + RING_OFF, g, S, E); } SEAM(6);
    if (IN(7)) { pg8::Gemm g{BIG, (const bf16*)(ws + WS_WDN), M, D, FF}; pg8::StaticOrder S; S.init(M, D, G, bx);
        { pg8::Unit u; for (int i = 0; S.next(i, u); ++i) ffn_fixup(u.pm, BIG, HPREV, HCUR, P.in[14], P.in[15]); VM_WAIT(); __syncthreads(); }
        pg8::EpiSum E{XF, P.out, nullptr, DN_ALPHA}; pg8::gemm_phase<pg8::EpiSum, pg8::StaticOrder, true, true>(lds + RING_OFF, g, S, E); } SEAM(7);
    if (IN(8)) { ln_pass(P.out, XB, ln_g + 1 * D, ln_b + 1 * D, vcu, G, wave, lane); } SEAM(8);
    if (IN(9)) { pg8::Gemm g{XB, (const bf16*)(ws + WS_WQKV), M, 3 * D, D}; pg8::StaticOrder S; S.init(M, 3 * D, G, bx);
        pg8::EpiBf16S E{Qb, D, D, (size_t)(16 * MiB), QSCALE}; pg8::gemm_phase<pg8::EpiBf16S, pg8::StaticOrder, true, true>(lds + RING_OFF, g, S, E); } SEAM(9);
    if (IN(10)) {
        for (int u = vcu; u < 512; u += G) { const int v = u & 255, pass = u >> 8, bh = v >> 3, s = v & 7, qb = pass ? 15 - s : s;
            sba::attn_unit<true>(bh >> 3, bh & 7, qb, Qb, Kb, Vb, Qb, (char*)lds_raw + RING_OFF); }
    } SEAM(10);
    if (IN(11)) { pg8::Gemm g{Qb, (const bf16*)(ws + WS_WAO), M, D, D}; pg8::StaticOrder S; S.init(M, D, G, bx);
        pg8::EpiSum E{P.out, XF, nullptr, DN_ALPHA}; pg8::gemm_phase<pg8::EpiSum, pg8::StaticOrder, true, true>(lds + RING_OFF, g, S, E); } SEAM(11);
    if (IN(12)) { ln_pass(XF, XB, ln_g + 2 * D, ln_b + 2 * D, vcu, G, wave, lane); } SEAM(12);
    if (IN(13)) { pg8::Gemm g{XB, (const bf16*)(ws + WS_WUP) + (size_t)6144 * 1024, M, 2 * FF, D}; pg8::StaticOrder S; S.init(M, 2 * FF, G, bx);
        pg8::EpiFfnUp E{BIG, P.in[14] + 3 * 6144, P.in[15] + 6144, HPREV, HCUR, (LAS float*)(lds + EXTRA_OFF)}; pg8::gemm_phase<pg8::EpiFfnUp, pg8::StaticOrder, true, true>(lds + RING_OFF, g, S, E); } SEAM(13);
    if (IN(14)) { pg8::Gemm g{BIG, (const bf16*)(ws + WS_WDN) + (size_t)1024 * 3072, M, D, FF}; pg8::StaticOrder S; S.init(M, D, G, bx);
        { pg8::Unit u; for (int i = 0; S.next(i, u); ++i) ffn_fixup(u.pm, BIG, HPREV, HCUR, P.in[14] + 3 * 6144, P.in[15] + 6144); VM_WAIT(); __syncthreads(); }
        pg8::EpiSum E{XF, P.out, nullptr, DN_ALPHA}; pg8::gemm_phase<pg8::EpiSum, pg8::StaticOrder, true, true>(lds + RING_OFF, g, S, E); } SEAM(14);
    if (IN(15)) { ln_pass(P.out, XB, ln_g + 3 * D, ln_b + 3 * D, vcu, G, wave, lane); }
#undef IN
#undef SEAM
}

extern "C" void kernel_launch(void* const* d_in, const int* in_sizes, int n_in, void* d_out, int out_size, void* d_ws, size_t ws_size, hipStream_t stream) {
    static int grid = 0;
    if (grid == 0) {
        if (n_in != 19 || in_sizes[0] != M * D || out_size != M * D || ws_size < WS_END) { fprintf(stderr, "kernel_launch: unexpected shapes (n_in %d, in0 %d, out %d, ws %zu)\n", n_in, n_in > 0 ? in_sizes[0] : -1, out_size, ws_size); grid = -1; return; }
        int dev = 0, cus = 0, per_cu = 0;
        if (hipGetDevice(&dev) != hipSuccess || hipDeviceGetAttribute(&cus, hipDeviceAttributeMultiprocessorCount, dev) != hipSuccess) { grid = -1; return; }
        if (hipFuncSetAttribute((const void*)yoco_fwd, hipFuncAttributeMaxDynamicSharedMemorySize, LDS_BYTES) != hipSuccess) { fprintf(stderr, "kernel_launch: hipFuncSetAttribute failed\n"); grid = -1; return; }
        if (hipOccupancyMaxActiveBlocksPerMultiprocessor(&per_cu, (const void*)yoco_fwd, NWAVES * 64, LDS_BYTES) != hipSuccess || per_cu < 1) { fprintf(stderr, "kernel_launch: occupancy query says %d blocks per CU\n", per_cu); per_cu = 1; }
        (void)hipGetLastError();
        grid = cus;
    }
    if (grid < 0) return;
    (void)hipMemsetAsync((char*)d_ws + WS_CTL, 0, CTL_ZERO_BYTES, stream);
    Args a{};
    for (int i = 0; i < 19; ++i) a.in[i] = (const float*)d_in[i];
    a.out = (float*)d_out; a.ws = (unsigned char*)d_ws;
#if MK_PER_PHASE
    for (int p = 0; p < N_PHASES; ++p) { a.ph_lo = p; a.ph_hi = p + 1; a.li = p; hipLaunchKernelGGL(yoco_fwd, dim3(grid), dim3(NWAVES * 64), LDS_BYTES, stream, a); }
#else
    a.ph_lo = 0; a.ph_hi = N_PHASES; a.li = 0;
    hipLaunchKernelGGL(yoco_fwd, dim3(grid), dim3(NWAVES * 64), LDS_BYTES, stream, a);
#endif
}
```
